# Optimizing an MI355X kernel written in HIP

```python
import math
import jax, jax.numpy as jnp
from jax import lax
import numpy as np

D_MODEL = 1024
BATCH = 8
SEQ = 4096
DEPTH = 1

CHUNK = 64
EPS = 1e-6

SSM_WIDTH = 512
SSM_GROUP = 16
SSM_GROUPS = SSM_WIDTH // SSM_GROUP
SSM_STATE = 64
DT_MIN = 1e-3
DT_MAX = 1e-1

ATT_HEADS = 8
HEAD_DIM = 128
ATT_WIDTH = ATT_HEADS * HEAD_DIM
Q_BLOCK = 128

N_BRANCHES = 2
IN_SPLITS = (
    SSM_WIDTH,
    SSM_WIDTH + ATT_WIDTH,
    SSM_WIDTH + 2 * ATT_WIDTH,
    SSM_WIDTH + 3 * ATT_WIDTH,
    SSM_WIDTH + 3 * ATT_WIDTH + ATT_HEADS,
    SSM_WIDTH + 3 * ATT_WIDTH + ATT_HEADS + D_MODEL,
)
IN_COLS = SSM_WIDTH + 3 * ATT_WIDTH + ATT_HEADS + N_BRANCHES * D_MODEL

PEER_HEADS = 8
PEER_KEYS = 128
PEER_EXPERTS = PEER_KEYS * PEER_KEYS
PEER_QUERY = 256
PEER_HALF = PEER_QUERY // 2
PEER_TOPK = 16
TOKEN_BLOCK = 128

kernel_name = "hybrid_s5_fox_peer_block"


def rms_norm(x, g):
    x32 = x.astype(jnp.float32)
    y = x32 * lax.rsqrt(jnp.mean(x32 * x32, axis=-1, keepdims=True) + EPS)
    return (y * g.astype(jnp.float32)).astype(x.dtype)


def _complex_affine_combine(earlier, later):
    ar1, ai1, br1, bi1 = earlier
    ar2, ai2, br2, bi2 = later
    return (ar2 * ar1 - ai2 * ai1,
            ar2 * ai1 + ai2 * ar1,
            ar2 * br1 - ai2 * bi1 + br2,
            ar2 * bi1 + ai2 * br1 + bi2)


def s5_branch(u, a_re, a_im, log_step, b_re, b_im, c_re, c_im, d_skip, w_glu):
    bsz, seq = u.shape[0], u.shape[1]
    f32 = jnp.float32
    u32 = u.astype(f32)
    ug = u32.reshape(bsz, seq, SSM_GROUPS, SSM_GROUP)
    step = jnp.exp(log_step.astype(f32))[:, None]
    ar = a_re.astype(f32)
    ai = a_im.astype(f32)
    mag = jnp.exp(ar * step)
    lam_re = mag * jnp.cos(ai * step)
    lam_im = mag * jnp.sin(ai * step)
    nr = lam_re - 1.0
    ni = lam_im
    den = ar * ar + ai * ai
    coef_re = (nr * ar + ni * ai) / den
    coef_im = (ni * ar - nr * ai) / den
    br = coef_re[..., None] * b_re.astype(f32) - coef_im[..., None] * b_im.astype(f32)
    bi = coef_re[..., None] * b_im.astype(f32) + coef_im[..., None] * b_re.astype(f32)
    xr = jnp.einsum('blgh,gph->blgp', ug, br)
    xi = jnp.einsum('blgh,gph->blgp', ug, bi)
    lr = jnp.broadcast_to(lam_re[None, None], (1, seq, SSM_GROUPS, SSM_STATE))
    li = jnp.broadcast_to(lam_im[None, None], (1, seq, SSM_GROUPS, SSM_STATE))
    _, _, sr, si = lax.associative_scan(_complex_affine_combine, (lr, li, xr, xi), axis=1)
    y = (jnp.einsum('blgp,ghp->blgh', sr, c_re.astype(f32))
         - jnp.einsum('blgp,ghp->blgh', si, c_im.astype(f32)))
    y = y.reshape(bsz, seq, SSM_WIDTH) + d_skip.astype(f32) * u32
    y = jax.nn.gelu(y).astype(u.dtype)
    z = y @ w_glu
    val, gate = jnp.split(z, 2, axis=-1)
    return val * jax.nn.sigmoid(gate)


def head_rms_norm(x, g):
    x32 = x.astype(jnp.float32)
    y = x32 * lax.rsqrt(jnp.mean(x32 * x32, axis=-1, keepdims=True) + EPS)
    return (y * g.astype(jnp.float32)).astype(x.dtype)


def forgetting_attention(q, k, v, f_logit, f_bias, q_g, k_g):
    bsz, seq = q.shape[0], q.shape[1]
    q = head_rms_norm(q.reshape(bsz, seq, ATT_HEADS, HEAD_DIM), q_g).transpose(0, 2, 1, 3)
    k = head_rms_norm(k.reshape(bsz, seq, ATT_HEADS, HEAD_DIM), k_g).transpose(0, 2, 1, 3)
    v = v.reshape(bsz, seq, ATT_HEADS, HEAD_DIM).transpose(0, 2, 1, 3)
    log_f = jax.nn.log_sigmoid((f_logit + f_bias).astype(jnp.float32)).transpose(0, 2, 1)
    cum = jnp.cumsum(log_f, axis=-1)
    n_blk = seq // Q_BLOCK
    q_blocks = q.reshape(bsz, ATT_HEADS, n_blk, Q_BLOCK, HEAD_DIM).transpose(2, 0, 1, 3, 4)
    c_blocks = cum.reshape(bsz, ATT_HEADS, n_blk, Q_BLOCK).transpose(2, 0, 1, 3)
    key_pos = jnp.arange(seq)
    scale = HEAD_DIM ** -0.5

    def one_block(args):
        blk, q_blk, c_blk = args
        s = jnp.einsum('bhqd,bhkd->bhqk', q_blk, k).astype(jnp.float32) * scale
        s = s + c_blk[..., None] - cum[:, :, None, :]
        q_pos = blk * Q_BLOCK + jnp.arange(Q_BLOCK)
        s = jnp.where(key_pos[None, :] <= q_pos[:, None], s, -jnp.inf)
        p = jax.nn.softmax(s, axis=-1)
        return jnp.einsum('bhqk,bhkd->bhqd', p.astype(v.dtype), v)

    o = lax.map(one_block, (jnp.arange(n_blk), q_blocks, c_blocks))
    return o.transpose(1, 0, 3, 2, 4).reshape(bsz, seq, ATT_WIDTH)


def peer_ffn(h, w_query, sub_keys, u_tab, v_tab):
    bsz, seq, d = h.shape
    q = (h @ w_query).reshape(bsz, seq, PEER_HEADS, 2, PEER_HALF).astype(jnp.float32)
    scores = jnp.einsum('blhcd,hckd->blhck', q, sub_keys.astype(jnp.float32))
    s_top, i_top = lax.top_k(scores, PEER_TOPK)
    cand_s = (s_top[..., 0, :, None] + s_top[..., 1, None, :]).reshape(bsz, seq, PEER_HEADS, PEER_TOPK * PEER_TOPK)
    cand_i = (i_top[..., 0, :, None] * PEER_KEYS + i_top[..., 1, None, :]).reshape(bsz, seq, PEER_HEADS, PEER_TOPK * PEER_TOPK)
    best_s, pos = lax.top_k(cand_s, PEER_TOPK)
    expert_idx = jnp.take_along_axis(cand_i, pos, axis=-1)
    gates = jax.nn.softmax(best_s, axis=-1)
    n_tok = bsz * seq
    n_tb = n_tok // TOKEN_BLOCK
    h_blocks = h.reshape(n_tb, TOKEN_BLOCK, d)
    i_blocks = expert_idx.reshape(n_tb, TOKEN_BLOCK, PEER_HEADS, PEER_TOPK)
    g_blocks = gates.reshape(n_tb, TOKEN_BLOCK, PEER_HEADS, PEER_TOPK)

    def one_block(args):
        h_blk, i_blk, g_blk = args
        u_sel = u_tab[i_blk]
        act = jax.nn.gelu(jnp.einsum('td,thkd->thk', h_blk, u_sel).astype(jnp.float32))
        w = (g_blk * act).astype(h.dtype)
        return jnp.einsum('thk,thkd->td', w, v_tab[i_blk])

    out = lax.map(one_block, (h_blocks, i_blocks, g_blocks))
    return out.reshape(bsz, seq, d)


def setup_inputs(seed: int = 0) -> dict:
    key = jax.random.key(seed)
    ks = jax.random.split(key, 21)
    f32 = jnp.float32
    nrm = lambda k, shape: jax.random.normal(k, shape, dtype=f32)
    x = nrm(ks[0], (BATCH, SEQ, D_MODEL))
    mix_norm_g = 1.0 + 0.02 * nrm(ks[1], (DEPTH, D_MODEL))
    w_in = nrm(ks[2], (DEPTH, D_MODEL, IN_COLS)) * D_MODEL ** -0.5
    ssm_a_re = -0.5 + 0.01 * nrm(ks[3], (DEPTH, SSM_GROUPS, SSM_STATE))
    ssm_a_im = math.pi * jnp.arange(SSM_STATE, dtype=f32) + 0.01 * nrm(ks[4], (DEPTH, SSM_GROUPS, SSM_STATE))
    ssm_log_step = jax.random.uniform(ks[5], (DEPTH, SSM_GROUPS), dtype=f32, minval=math.log(DT_MIN), maxval=math.log(DT_MAX))
    ssm_b_re = nrm(ks[6], (DEPTH, SSM_GROUPS, SSM_STATE, SSM_GROUP)) * (2.0 * SSM_GROUP) ** -0.5
    ssm_b_im = nrm(ks[7], (DEPTH, SSM_GROUPS, SSM_STATE, SSM_GROUP)) * (2.0 * SSM_GROUP) ** -0.5
    ssm_c_re = nrm(ks[8], (DEPTH, SSM_GROUPS, SSM_GROUP, SSM_STATE)) * (2.0 * SSM_STATE) ** -0.5
    ssm_c_im = nrm(ks[9], (DEPTH, SSM_GROUPS, SSM_GROUP, SSM_STATE)) * (2.0 * SSM_STATE) ** -0.5
    ssm_d = nrm(ks[10], (DEPTH, SSM_WIDTH))
    ssm_w_glu = nrm(ks[11], (DEPTH, SSM_WIDTH, 2 * D_MODEL)) * SSM_WIDTH ** -0.5
    fox_forget_bias = 2.0 + 0.5 * nrm(ks[12], (DEPTH, ATT_HEADS))
    q_norm_g = 1.0 + 0.02 * nrm(ks[13], (DEPTH, HEAD_DIM))
    k_norm_g = 1.0 + 0.02 * nrm(ks[14], (DEPTH, HEAD_DIM))
    w_out = nrm(ks[15], (DEPTH, D_MODEL, D_MODEL)) * D_MODEL ** -0.5
    ffn_norm_g = 1.0 + 0.02 * nrm(ks[16], (DEPTH, D_MODEL))
    peer_w_query = nrm(ks[17], (DEPTH, D_MODEL, PEER_HEADS * PEER_QUERY)) * D_MODEL ** -0.5
    peer_sub_keys = nrm(ks[18], (DEPTH, PEER_HEADS, 2, PEER_KEYS, PEER_HALF)) * PEER_HALF ** -0.5
    peer_u = nrm(ks[19], (DEPTH, PEER_EXPERTS, D_MODEL)) * D_MODEL ** -0.5
    peer_v = nrm(ks[20], (DEPTH, PEER_EXPERTS, D_MODEL)) * 0.1
    return {"x": x, "mix_norm_g": mix_norm_g, "w_in": w_in,
            "ssm_a_re": ssm_a_re, "ssm_a_im": ssm_a_im, "ssm_log_step": ssm_log_step,
            "ssm_b_re": ssm_b_re, "ssm_b_im": ssm_b_im, "ssm_c_re": ssm_c_re, "ssm_c_im": ssm_c_im,
            "ssm_d": ssm_d, "ssm_w_glu": ssm_w_glu, "fox_forget_bias": fox_forget_bias,
            "q_norm_g": q_norm_g, "k_norm_g": k_norm_g, "w_out": w_out, "ffn_norm_g": ffn_norm_g,
            "peer_w_query": peer_w_query, "peer_sub_keys": peer_sub_keys,
            "peer_u": peer_u, "peer_v": peer_v}


def reference(x, mix_norm_g, w_in, ssm_a_re, ssm_a_im, ssm_log_step, ssm_b_re, ssm_b_im,
              ssm_c_re, ssm_c_im, ssm_d, ssm_w_glu, fox_forget_bias, q_norm_g, k_norm_g,
              w_out, ffn_norm_g, peer_w_query, peer_sub_keys, peer_u, peer_v):
    for layer in range(DEPTH):
        h = rms_norm(x, mix_norm_g[layer])
        proj = h @ w_in[layer]
        u, q, k, v, f_logit, g_ssm, g_att = jnp.split(proj, IN_SPLITS, axis=-1)
        y_ssm = s5_branch(u, ssm_a_re[layer], ssm_a_im[layer], ssm_log_step[layer],
                          ssm_b_re[layer], ssm_b_im[layer], ssm_c_re[layer], ssm_c_im[layer],
                          ssm_d[layer], ssm_w_glu[layer])
        y_att = forgetting_attention(q, k, v, f_logit, fox_forget_bias[layer],
                                     q_norm_g[layer], k_norm_g[layer])
        merged = jax.nn.sigmoid(g_ssm) * y_ssm + jax.nn.sigmoid(g_att) * y_att
        x = x + (merged @ w_out[layer]).astype(x.dtype)
        h2 = rms_norm(x, ffn_norm_g[layer])
        x = x + peer_ffn(h2, peer_w_query[layer], peer_sub_keys[layer],
                         peer_u[layer], peer_v[layer]).astype(x.dtype)
    return x
```

```cpp
#include <hip/hip_runtime.h>
#include <hip/hip_cooperative_groups.h>
#include <stdint.h>
#include <cstdio>
namespace cg = cooperative_groups;

#ifndef FUSED
#define FUSED 1
#define LASTPH 8

#define DUMPSUB 0
#endif

#define DI __device__ __forceinline__
typedef unsigned short u16;
typedef unsigned long long u64;
using bf16x8 = __attribute__((ext_vector_type(8))) short;
using s16x4 = __attribute__((ext_vector_type(4))) short;
using f32x16 = __attribute__((ext_vector_type(16))) float;
using f32x4 = __attribute__((ext_vector_type(4))) float;

constexpr int NTOK = 32768;
constexpr float EPS = 1e-6f;

constexpr size_t MB64 = 67108864ull;
constexpr size_t OFF_WIN = 0;
constexpr size_t OFF_WGLU = OFF_WIN + 5888ull * 1024 * 2;
constexpr size_t OFF_WOUT = OFF_WGLU + 2048ull * 512 * 2;
constexpr size_t OFF_WQ = OFF_WOUT + 1024ull * 1024 * 2;
constexpr size_t OFF_SK = OFF_WQ + 2048ull * 1024 * 2;
constexpr size_t OFF_UBF = OFF_SK + 8ull * 2 * 128 * 128 * 2;
constexpr size_t OFF_VBF = OFF_UBF + 16384ull * 1024 * 2;
constexpr size_t OFF_H = OFF_VBF + 16384ull * 1024 * 2;
constexpr size_t OFF_U = OFF_H + MB64;
constexpr size_t OFF_Q = OFF_U + MB64 / 2;
constexpr size_t OFF_K = OFF_Q + MB64;
constexpr size_t OFF_V = OFF_K + MB64;
constexpr size_t OFF_GS = OFF_V + MB64;
constexpr size_t OFF_GA = OFF_GS + MB64;
constexpr size_t OFF_LOGF = OFF_GA + MB64;
constexpr size_t OFF_CUM = OFF_LOGF + 1048576;
constexpr size_t OFF_LAM = OFF_CUM + 1048576;
constexpr size_t OFF_BB = OFF_LAM + 16384;
constexpr size_t OFF_CM = OFF_BB + 131072;
constexpr size_t OFF_CTR = OFF_CM + 131072;
constexpr size_t OFF_BAR = OFF_CTR + 256;
constexpr size_t OFF_E = OFF_BAR + 16384;
constexpr size_t WS_NEED = OFF_E + 524288;

struct Params {
  const float *x, *mix_g, *w_in, *a_re, *a_im, *log_step, *b_re, *b_im, *c_re, *c_im, *ssm_d, *w_glu,
      *f_bias, *q_g, *k_g, *w_out, *ffn_g, *w_query, *sub_keys, *peer_u, *peer_v;
  float* out;
  char* ws;
};

constexpr int LDS_BYTES = 74752;

typedef __bf16 bf16v2 __attribute__((ext_vector_type(2)));
DI unsigned f2bf(float x) { return (unsigned)__builtin_bit_cast(unsigned short, (__bf16)x); }
DI unsigned pk2(float a, float b) { bf16v2 v = {(__bf16)a, (__bf16)b}; return __builtin_bit_cast(unsigned, v); }
DI float bflo(unsigned u) { return __uint_as_float(u << 16); }
DI float bfhi(unsigned u) { return __uint_as_float(u & 0xffff0000u); }
DI float bf2f(u16 b) { return __uint_as_float(((unsigned)b) << 16); }
DI f32x16 mfma32(bf16x8 a, bf16x8 b, f32x16 c) { return __builtin_amdgcn_mfma_f32_32x32x16_bf16(a, b, c, 0, 0, 0); }
DI f32x4 mfma16(bf16x8 a, bf16x8 b, f32x4 c) { return __builtin_amdgcn_mfma_f32_16x16x32_bf16(a, b, c, 0, 0, 0); }
DI float sigmoidf_(float x) { return __builtin_amdgcn_rcpf(1.f + __expf(-x)); }
DI float gelu_tanh(float x) {
  float z = 0.7978845608028654f * (x + 0.044715f * x * x * x);
  float t = 1.f - 2.f * __builtin_amdgcn_rcpf(__expf(2.f * z) + 1.f);
  return 0.5f * x * (1.f + t);
}
DI float log_sigmoid(float z) { return fminf(z, 0.f) - log1pf(__expf(-fabsf(z))); }
DI int crow(int i, int hh) { return (i & 3) + 8 * (i >> 2) + 4 * hh; }
DI uint4 ld16(const void* p) { return *(const uint4*)p; }
DI bf16x8 as_bf(uint4 v) { return __builtin_bit_cast(bf16x8, v); }
DI uint4 add_bf8(uint4 a, uint4 b) {
  uint4 o;
  o.x = pk2(bflo(a.x) + bflo(b.x), bfhi(a.x) + bfhi(b.x));
  o.y = pk2(bflo(a.y) + bflo(b.y), bfhi(a.y) + bfhi(b.y));
  o.z = pk2(bflo(a.z) + bflo(b.z), bfhi(a.z) + bfhi(b.z));
  o.w = pk2(bflo(a.w) + bflo(b.w), bfhi(a.w) + bfhi(b.w));
  return o;
}
DI unsigned srt(float f) { unsigned u = __float_as_uint(f); return (u & 0x80000000u) ? ~u : (u | 0x80000000u); }
DI float unsrt(unsigned k) { unsigned u = (k & 0x80000000u) ? (k & 0x7fffffffu) : ~k; return __uint_as_float(u); }

DI void cvt_rows8(const float* __restrict__ src, u16* __restrict__ dst, size_t n8, size_t gtid, size_t nthr) {
  const float4* s = (const float4*)src;
  uint4* d = (uint4*)dst;
  for (size_t i = gtid; i < n8; i += nthr) {
    float4 a = s[2 * i], b = s[2 * i + 1];
    uint4 o;
    o.x = pk2(a.x, a.y); o.y = pk2(a.z, a.w); o.z = pk2(b.x, b.y); o.w = pk2(b.z, b.w);
    d[i] = o;
  }
}


typedef float f32x2 __attribute__((ext_vector_type(2)));
DI void cvt_rows_fp8(const float* __restrict__ src, unsigned char* __restrict__ dst, size_t n16, float scale, size_t gtid, size_t nthr) {
  const float4* s = (const float4*)src;
  uint4* d = (uint4*)dst;
  for (size_t i = gtid; i < n16; i += nthr) {
    float4 a = s[4 * i], b = s[4 * i + 1], c = s[4 * i + 2], e = s[4 * i + 3];
    uint4 o;
    int w;
    w = __builtin_amdgcn_cvt_pk_fp8_f32(a.x * scale, a.y * scale, 0, false); w = __builtin_amdgcn_cvt_pk_fp8_f32(a.z * scale, a.w * scale, w, true); o.x = (unsigned)w;
    w = __builtin_amdgcn_cvt_pk_fp8_f32(b.x * scale, b.y * scale, 0, false); w = __builtin_amdgcn_cvt_pk_fp8_f32(b.z * scale, b.w * scale, w, true); o.y = (unsigned)w;
    w = __builtin_amdgcn_cvt_pk_fp8_f32(c.x * scale, c.y * scale, 0, false); w = __builtin_amdgcn_cvt_pk_fp8_f32(c.z * scale, c.w * scale, w, true); o.z = (unsigned)w;
    w = __builtin_amdgcn_cvt_pk_fp8_f32(e.x * scale, e.y * scale, 0, false); w = __builtin_amdgcn_cvt_pk_fp8_f32(e.z * scale, e.w * scale, w, true); o.w = (unsigned)w;
    d[i] = o;
  }
}
DI uint2 fp8x4_to_bf16x4(unsigned w) {
  uint2 o;
  o.x = __builtin_bit_cast(unsigned, __builtin_amdgcn_cvt_scalef32_pk_bf16_fp8((int)w, 1.0f, false));
  o.y = __builtin_bit_cast(unsigned, __builtin_amdgcn_cvt_scalef32_pk_bf16_fp8((int)w, 1.0f, true));
  return o;
}
constexpr float U_SCALE = 64.f, V_SCALE = 16.f;

template <bool WITH_F>
DI void rmsnorm_rows_t(const Params& p, const float* __restrict__ src, const float* __restrict__ g, u16* __restrict__ dst) {
  const int lane = threadIdx.x & 63;
  const int gw = blockIdx.x * 4 + (threadIdx.x >> 6), nw = gridDim.x * 4;
  float4 gv[4];
#pragma unroll
  for (int i = 0; i < 4; ++i) gv[i] = ((const float4*)g)[lane + 64 * i];
  float wf[WITH_F ? 128 : 1];
  if (WITH_F) {
#pragma unroll
    for (int i = 0; i < 4; ++i)
#pragma unroll
      for (int e = 0; e < 4; ++e) {
        const float4* wp = (const float4*)(p.w_in + (size_t)(4 * (lane + 64 * i) + e) * 5640 + 3584);
        const float4 a = wp[0], b = wp[1];
        float* d = wf + (i * 4 + e) * 8;
        d[0] = a.x; d[1] = a.y; d[2] = a.z; d[3] = a.w; d[4] = b.x; d[5] = b.y; d[6] = b.z; d[7] = b.w;
      }
  }
  for (int row = gw; row < NTOK; row += nw) {
    const float4* s = (const float4*)(src + (size_t)row * 1024);
    float4 v[4];
    float ss = 0.f;
#pragma unroll
    for (int i = 0; i < 4; ++i) {
      v[i] = s[lane + 64 * i];
      ss += v[i].x * v[i].x + v[i].y * v[i].y + v[i].z * v[i].z + v[i].w * v[i].w;
    }
#pragma unroll
    for (int d = 32; d >= 1; d >>= 1) ss += __shfl_xor(ss, d);
    const float rs = rsqrtf(ss * (1.f / 1024.f) + EPS);
    uint2* o = (uint2*)(dst + (size_t)row * 1024);
    float fd[8];
    if (WITH_F) {
#pragma unroll
      for (int h = 0; h < 8; ++h) fd[h] = 0.f;
    }
#pragma unroll
    for (int i = 0; i < 4; ++i) {
      const float y0 = v[i].x * rs * gv[i].x, y1 = v[i].y * rs * gv[i].y, y2 = v[i].z * rs * gv[i].z, y3 = v[i].w * rs * gv[i].w;
      uint2 w;
      w.x = pk2(y0, y1);
      w.y = pk2(y2, y3);
      o[lane + 64 * i] = w;
      if (WITH_F) {
#pragma unroll
        for (int h = 0; h < 8; ++h)
          fd[h] += y0 * wf[(i * 4 + 0) * 8 + h] + y1 * wf[(i * 4 + 1) * 8 + h] + y2 * wf[(i * 4 + 2) * 8 + h] + y3 * wf[(i * 4 + 3) * 8 + h];
      }
    }
    if (WITH_F) {
#pragma unroll
      for (int h = 0; h < 8; ++h)
#pragma unroll
        for (int d = 32; d >= 1; d >>= 1) fd[h] += __shfl_xor(fd[h], d);
      float mine = fd[0];
#pragma unroll
      for (int h = 1; h < 8; ++h) mine = (lane == h) ? fd[h] : mine;
      if (lane < 8) {
        const int b = row >> 12, l = row & 4095;
        ((float*)(p.ws + OFF_LOGF))[(size_t)(b * 8 + lane) * 4096 + l] = log_sigmoid(mine + p.f_bias[lane]);
      }
    }
  }
}

DI int srccol(int mat, int n) {
  if (mat == 0) {
    if (n < 3584) return n;
    if (n < 5632) return n + 8;
    return -1;
  }
  if (mat == 1) {
    int c = n >> 6, wi = n & 63;
    return wi < 32 ? 32 * c + wi : 1024 + 32 * c + wi - 32;
  }
  return n;
}

DI void transpose_tile(const float* __restrict__ src, int Nsrc, int K, u16* __restrict__ dst, int k0, int n0, int mat, float* tl) {
  const int tid = threadIdx.x, c = tid & 63, r0 = tid >> 6;
  const int sc = srccol(mat, n0 + c);
#pragma unroll
  for (int i = 0; i < 16; ++i) {
    int rr = r0 + 4 * i;
    float v = sc >= 0 ? src[(size_t)(k0 + rr) * Nsrc + sc] : 0.f;
    tl[c * 65 + rr] = v;
  }
  __syncthreads();
  const int kk = (tid & 31) * 2, c0 = tid >> 5;
#pragma unroll
  for (int i = 0; i < 8; ++i) {
    int cc = c0 + 8 * i;
    unsigned o = pk2(tl[cc * 65 + kk], tl[cc * 65 + kk + 1]);
    *(unsigned*)(dst + (size_t)(n0 + cc) * K + k0 + kk) = o;
  }
  __syncthreads();
}

DI void phase_prep(const Params& p, char* lds) {
  const int tid = threadIdx.x;
  const size_t nthr = (size_t)gridDim.x * 256, gtid = (size_t)blockIdx.x * 256 + tid;
  if (gtid == 0) {
    int* ctr = (int*)(p.ws + OFF_CTR);
    for (int i = 0; i < 16; ++i) ctr[i] = 0;
  }
  if (gtid < 2048) {
    const int g = (int)gtid >> 6, pp = (int)gtid & 63;
    const float step = expf(p.log_step[g]);
    const float ar = p.a_re[g * 64 + pp], ai = p.a_im[g * 64 + pp];
    const float mag = expf(ar * step);
    const float lr = mag * cosf(ai * step), li = mag * sinf(ai * step);
    const float nr = lr - 1.f, ni = li, den = ar * ar + ai * ai;
    const float cr = (nr * ar + ni * ai) / den, ci = (ni * ar - nr * ai) / den;
    float* lam = (float*)(p.ws + OFF_LAM);
    lam[(g * 64 + pp) * 2] = lr;
    lam[(g * 64 + pp) * 2 + 1] = li;
    u16* bb = (u16*)(p.ws + OFF_BB);
    u16* cm = (u16*)(p.ws + OFF_CM);
    for (int h = 0; h < 16; ++h) {
      float bre = p.b_re[(g * 64 + pp) * 16 + h], bim = p.b_im[(g * 64 + pp) * 16 + h];
      bb[(g * 128 + pp) * 16 + h] = (u16)f2bf(cr * bre - ci * bim);
      bb[(g * 128 + 64 + pp) * 16 + h] = (u16)f2bf(cr * bim + ci * bre);
      cm[(g * 16 + h) * 128 + pp] = (u16)f2bf(p.c_re[(g * 16 + h) * 64 + pp]);
      cm[(g * 16 + h) * 128 + 64 + pp] = (u16)f2bf(-p.c_im[(g * 16 + h) * 64 + pp]);
    }
  }
  {
    float* tl = (float*)lds;
    for (int t = blockIdx.x; t < 2432; t += gridDim.x) {
      if (t < 1408) {
        int kt = t % 16, nt = t / 16;
        transpose_tile(p.w_in, 5640, 1024, (u16*)(p.ws + OFF_WIN), kt * 64, nt * 64, 0, tl);
      } else if (t < 1664) {
        int u = t - 1408, kt = u % 8, nt = u / 8;
        transpose_tile(p.w_glu, 2048, 512, (u16*)(p.ws + OFF_WGLU), kt * 64, nt * 64, 1, tl);
      } else if (t < 1920) {
        int u = t - 1664, kt = u % 16, nt = u / 16;
        transpose_tile(p.w_out, 1024, 1024, (u16*)(p.ws + OFF_WOUT), kt * 64, nt * 64, 2, tl);
      } else {
        int u = t - 1920, kt = u % 16, nt = u / 16;
        transpose_tile(p.w_query, 2048, 1024, (u16*)(p.ws + OFF_WQ), kt * 64, nt * 64, 3, tl);
      }
    }
  }
  rmsnorm_rows_t<true>(p, p.x, p.mix_g, (u16*)(p.ws + OFF_H));
  cvt_rows8(p.sub_keys, (u16*)(p.ws + OFF_SK), 8ull * 2 * 128 * 128 / 8, gtid, nthr);

}

enum { G_INPROJ = 0, G_GLU = 1, G_OUT = 2, G_PQ = 3 };

#define RAW_BARRIER() do { asm volatile("s_waitcnt lgkmcnt(0)" ::: "memory"); __builtin_amdgcn_s_barrier(); asm volatile("" ::: "memory"); } while (0)

template <int K, int MODE>
DI void gemm_tile(const Params& p, const u16* __restrict__ A, const u16* __restrict__ W, int mt, int nt, char* lds) {
  constexpr int WB = 256 * 64, AB = 128 * 64, SB = WB + AB;
  constexpr int NK = K / 32;
  const int tid = threadIdx.x, lane = tid & 63, w = tid >> 6, wn = w >> 1, wm = w & 1, r = lane & 31, hh = lane >> 5;
  const int lrow = tid >> 2, gc = (tid & 3) ^ ((tid >> 4) & 3);
  const u16* gW = W + (size_t)(nt * 256 + lrow) * K + gc * 8;
  const u16* gA = A + (size_t)(mt * 128 + lrow) * K + gc * 8;
  f32x16 acc[4][2];
#pragma unroll
  for (int a = 0; a < 4; ++a)
#pragma unroll
    for (int b = 0; b < 2; ++b)
#pragma unroll
      for (int i = 0; i < 16; ++i) acc[a][b][i] = 0.f;
  auto issue = [&](int kt, int st) {
    char* base = lds + st * SB + tid * 16;
#pragma unroll
    for (int i = 0; i < 4; ++i)
      __builtin_amdgcn_global_load_lds((const unsigned*)(gW + (size_t)(64 * i) * K + kt * 32),
                                       (__attribute__((address_space(3))) unsigned*)(base + i * 4096), 16, 0, 0);
#pragma unroll
    for (int i = 0; i < 2; ++i)
      __builtin_amdgcn_global_load_lds((const unsigned*)(gA + (size_t)(64 * i) * K + kt * 32),
                                       (__attribute__((address_space(3))) unsigned*)(base + WB + i * 4096), 16, 0, 0);
  };
  const int sw = (r >> 2) & 3;
  asm volatile("s_waitcnt vmcnt(0)" ::: "memory");
  RAW_BARRIER();
  issue(0, 0); issue(1, 1);
  int cs = 0, ls = 2;
  for (int kt = 0; kt < NK; ++kt) {
    if (kt + 1 < NK) asm volatile("s_waitcnt vmcnt(6)" ::: "memory");
    else asm volatile("s_waitcnt vmcnt(0)" ::: "memory");
    RAW_BARRIER();
    if (kt + 2 < NK) issue(kt + 2, ls);
    const char* lw = lds + cs * SB + (wn * 128 + r) * 64;
    const char* la = lds + cs * SB + WB + (wm * 64 + r) * 64;
#pragma unroll
    for (int s = 0; s < 2; ++s) {
      bf16x8 fw[4], fa[2];
      const int po = ((2 * s + hh) ^ sw) * 16;
#pragma unroll
      for (int j = 0; j < 4; ++j) fw[j] = *(const bf16x8*)(lw + j * 32 * 64 + po);
#pragma unroll
      for (int j = 0; j < 2; ++j) fa[j] = *(const bf16x8*)(la + j * 32 * 64 + po);
#pragma unroll
      for (int nb = 0; nb < 4; ++nb)
#pragma unroll
        for (int mb = 0; mb < 2; ++mb) acc[nb][mb] = mfma32(fw[nb], fa[mb], acc[nb][mb]);
    }
    cs = cs == 2 ? 0 : cs + 1;
    ls = ls == 2 ? 0 : ls + 1;
  }
  const int mbase = mt * 128 + wm * 64 + r;
  const int nc = 2 * nt + wn;
  if (MODE == G_INPROJ) {
    const bool isq = (nc >= 4 && nc < 12);
#pragma unroll
    for (int nb = 0; nb < 4; ++nb)
#pragma unroll
      for (int mb = 0; mb < 2; ++mb)
#pragma unroll
        for (int ig = 0; ig < 4; ++ig) {
          const int nl = nb * 32 + ig * 8 + hh * 4;
          const int m = mbase + mb * 32;
          float v0 = acc[nb][mb][4 * ig], v1 = acc[nb][mb][4 * ig + 1], v2 = acc[nb][mb][4 * ig + 2], v3 = acc[nb][mb][4 * ig + 3];
          if (nc < 4) {
            uint2 o; o.x = pk2(v0, v1); o.y = pk2(v2, v3);
            *(uint2*)((u16*)(p.ws + OFF_U) + (size_t)m * 512 + nc * 128 + nl) = o;
          } else if (nc < 20) {
            uint2 o; o.x = pk2(v0, v1); o.y = pk2(v2, v3);
            size_t off = isq ? OFF_Q : OFF_K;
            int hd = isq ? nc - 4 : nc - 12;
            *(uint2*)((u16*)(p.ws + off) + (size_t)m * 1024 + hd * 128 + nl) = o;
          } else if (nc < 28) {
            uint2 o; o.x = pk2(v0, v1); o.y = pk2(v2, v3);
            *(uint2*)((u16*)(p.ws + OFF_V) + (size_t)m * 1024 + (nc - 20) * 128 + nl) = o;
          } else if (nc < 44) {
            uint2 o; o.x = pk2(sigmoidf_(v0), sigmoidf_(v1)); o.y = pk2(sigmoidf_(v2), sigmoidf_(v3));
            size_t off = nc < 36 ? OFF_GS : OFF_GA;
            int cb = nc < 36 ? nc - 28 : nc - 36;
            *(uint2*)((u16*)(p.ws + off) + (size_t)m * 1024 + cb * 128 + nl) = o;
          } else if (nc == 44) {
            if (nb == 0 && ig == 0) {
              const int b = m >> 12, l = m & 4095;
              float* lf = (float*)(p.ws + OFF_LOGF);
              const int h0 = hh * 4;
              lf[(size_t)(b * 8 + h0 + 0) * 4096 + l] = log_sigmoid(v0 + p.f_bias[h0 + 0]);
              lf[(size_t)(b * 8 + h0 + 1) * 4096 + l] = log_sigmoid(v1 + p.f_bias[h0 + 1]);
              lf[(size_t)(b * 8 + h0 + 2) * 4096 + l] = log_sigmoid(v2 + p.f_bias[h0 + 2]);
              lf[(size_t)(b * 8 + h0 + 3) * 4096 + l] = log_sigmoid(v3 + p.f_bias[h0 + 3]);
            }
          }
        }
  } else if (MODE == G_GLU) {
#pragma unroll
    for (int j = 0; j < 2; ++j)
#pragma unroll
      for (int mb = 0; mb < 2; ++mb)
#pragma unroll
        for (int ig = 0; ig < 4; ++ig) {
          const int c = 2 * nc + j;
          const int n = 32 * c + ig * 8 + hh * 4;
          const int m = mbase + mb * 32;
          uint2 gs = *(const uint2*)((const u16*)(p.ws + OFF_GS) + (size_t)m * 1024 + n);
          uint2 ma = *(const uint2*)((const u16*)(p.ws + OFF_Q) + (size_t)m * 1024 + n);
          float y0 = acc[2 * j][mb][4 * ig] * sigmoidf_(acc[2 * j + 1][mb][4 * ig]) * bflo(gs.x) + bflo(ma.x);
          float y1 = acc[2 * j][mb][4 * ig + 1] * sigmoidf_(acc[2 * j + 1][mb][4 * ig + 1]) * bfhi(gs.x) + bfhi(ma.x);
          float y2 = acc[2 * j][mb][4 * ig + 2] * sigmoidf_(acc[2 * j + 1][mb][4 * ig + 2]) * bflo(gs.y) + bflo(ma.y);
          float y3 = acc[2 * j][mb][4 * ig + 3] * sigmoidf_(acc[2 * j + 1][mb][4 * ig + 3]) * bfhi(gs.y) + bfhi(ma.y);
          uint2 o; o.x = pk2(y0, y1); o.y = pk2(y2, y3);
          *(uint2*)((u16*)(p.ws + OFF_H) + (size_t)m * 1024 + n) = o;
        }
  } else {
#pragma unroll
    for (int nb = 0; nb < 4; ++nb)
#pragma unroll
      for (int mb = 0; mb < 2; ++mb)
#pragma unroll
        for (int ig = 0; ig < 4; ++ig) {
          const int n = nc * 128 + nb * 32 + ig * 8 + hh * 4;
          const int m = mbase + mb * 32;
          float v0 = acc[nb][mb][4 * ig], v1 = acc[nb][mb][4 * ig + 1], v2 = acc[nb][mb][4 * ig + 2], v3 = acc[nb][mb][4 * ig + 3];
          if (MODE == G_OUT) {
            float4 xv = *(const float4*)(p.x + (size_t)m * 1024 + n);
            xv.x += v0; xv.y += v1; xv.z += v2; xv.w += v3;
            *(float4*)(p.out + (size_t)m * 1024 + n) = xv;
          } else {
            uint2 o; o.x = pk2(v0, v1); o.y = pk2(v2, v3);
            *(uint2*)((u16*)(p.ws + OFF_V) + (size_t)m * 2048 + n) = o;
          }
        }
  }
}

DI void qknorm_rows(const Params& p) {
  const int lane = threadIdx.x & 63;
  const int gw = blockIdx.x * 4 + (threadIdx.x >> 6), nw = gridDim.x * 4;
  const int d0 = (lane & 7) * 16;
  for (int it = gw; it < 2 * NTOK; it += nw) {
    const int isk = it >= NTOK;
    const int row = isk ? it - NTOK : it;
    u16* base = (u16*)(p.ws + (isk ? OFF_K : OFF_Q)) + (size_t)row * 1024 + lane * 16;
    const float* g = (isk ? p.k_g : p.q_g) + d0;
    uint4 a = ld16(base), b = ld16(base + 8);
    float v[16];
    v[0] = bflo(a.x); v[1] = bfhi(a.x); v[2] = bflo(a.y); v[3] = bfhi(a.y); v[4] = bflo(a.z); v[5] = bfhi(a.z); v[6] = bflo(a.w); v[7] = bfhi(a.w);
    v[8] = bflo(b.x); v[9] = bfhi(b.x); v[10] = bflo(b.y); v[11] = bfhi(b.y); v[12] = bflo(b.z); v[13] = bfhi(b.z); v[14] = bflo(b.w); v[15] = bfhi(b.w);
    float ss = 0.f;
#pragma unroll
    for (int i = 0; i < 16; ++i) ss += v[i] * v[i];
    ss += __shfl_xor(ss, 1); ss += __shfl_xor(ss, 2); ss += __shfl_xor(ss, 4);
    const float rs = rsqrtf(ss * (1.f / 128.f) + EPS) * (isk ? 1.f : 0.08838834764831845f * 1.4426950408889634f);
#pragma unroll
    for (int i = 0; i < 16; ++i) v[i] *= rs * g[i];
    uint4 oa, ob;
    oa.x = pk2(v[0], v[1]); oa.y = pk2(v[2], v[3]); oa.z = pk2(v[4], v[5]); oa.w = pk2(v[6], v[7]);
    ob.x = pk2(v[8], v[9]); ob.y = pk2(v[10], v[11]); ob.z = pk2(v[12], v[13]); ob.w = pk2(v[14], v[15]);
    *(uint4*)base = oa; *(uint4*)(base + 8) = ob;
  }
}

template <int MODE>
DI void s5_item(const Params& p, int bg, int seg, char* ldsw) {
  const int lane = threadIdx.x & 63, r = lane & 31, hh = lane >> 5, c15 = lane & 15, quad = lane >> 4;
  const int b = bg >> 5, g = bg & 31;
  float* X = (float*)ldsw;
  const u16* bbp = (const u16*)(p.ws + OFF_BB);
  const u16* cmp = (const u16*)(p.ws + OFF_CM);
  bf16x8 Bf[4], Cf[4];
#pragma unroll
  for (int nb = 0; nb < 4; ++nb) Bf[nb] = as_bf(ld16(bbp + (g * 128 + nb * 32 + r) * 16 + hh * 8));
#pragma unroll
  for (int ks = 0; ks < 4; ++ks) Cf[ks] = as_bf(ld16(cmp + (g * 16 + c15) * 128 + ks * 32 + quad * 8));
  const float* lam = (const float*)(p.ws + OFF_LAM);
  const float lr = lam[(g * 64 + lane) * 2], li = lam[(g * 64 + lane) * 2 + 1];
  const float dsk = p.ssm_d[g * 16 + c15];
  u16* ub = (u16*)(p.ws + OFF_U) + (size_t)b * 4096 * 512 + g * 16;
  float sr = 0.f, si = 0.f;
  float2* Eg = (float2*)(p.ws + OFF_E) + (size_t)bg * 256;
  if (MODE == 1 && seg > 0) {
    float pr = lr, pi = li;
#pragma unroll
    for (int i = 0; i < 10; ++i) { const float nr = pr * pr - pi * pi, ni = 2.f * pr * pi; pr = nr; pi = ni; }
    for (int k = 0; k < seg; ++k) {
      const float2 e = Eg[k * 64 + lane];
      const float nr = pr * sr - pi * si + e.x, ni = pr * si + pi * sr + e.y;
      sr = nr; si = ni;
    }
  }
  const int cbeg = seg * 32;
  u16* Ul = (u16*)(ldsw + 16896);
  uint4 a_next = ld16(ub + (size_t)(cbeg * 32 + r) * 512 + hh * 8);
#pragma unroll 1
  for (int c = cbeg; c < cbeg + 32; ++c) {
    const int t0 = c * 32;
    const bf16x8 a = as_bf(a_next);
    if (MODE == 1) *(uint4*)(Ul + r * 16 + hh * 8) = a_next;
    if (c + 1 < cbeg + 32) a_next = ld16(ub + (size_t)((c + 1) * 32 + r) * 512 + hh * 8);
#pragma unroll
    for (int nb = 0; nb < 4; ++nb) {
      f32x16 z;
#pragma unroll
      for (int i = 0; i < 16; ++i) z[i] = 0.f;
      z = mfma32(a, Bf[nb], z);
#pragma unroll
      for (int i = 0; i < 16; ++i) X[crow(i, hh) * 132 + nb * 32 + r] = z[i];
    }
    __builtin_amdgcn_fence(__ATOMIC_RELEASE, "wavefront");
    __builtin_amdgcn_wave_barrier();
    __builtin_amdgcn_fence(__ATOMIC_ACQUIRE, "wavefront");
    float xr[32], xi[32];
#pragma unroll
    for (int t = 0; t < 32; ++t) { xr[t] = X[t * 132 + lane]; xi[t] = X[t * 132 + 64 + lane]; }
#pragma unroll
    for (int t = 0; t < 32; ++t) {
      float nsr = lr * sr - li * si + xr[t];
      float nsi = lr * si + li * sr + xi[t];
      sr = nsr; si = nsi;
      xr[t] = sr; xi[t] = si;
    }
    if (MODE == 1) {
#pragma unroll
    for (int t = 0; t < 32; ++t) { X[t * 132 + lane] = xr[t]; X[t * 132 + 64 + lane] = xi[t]; }
    __builtin_amdgcn_fence(__ATOMIC_RELEASE, "wavefront");
    __builtin_amdgcn_wave_barrier();
    __builtin_amdgcn_fence(__ATOMIC_ACQUIRE, "wavefront");
#pragma unroll
    for (int mb = 0; mb < 2; ++mb) {
      f32x4 y = {0.f, 0.f, 0.f, 0.f};
#pragma unroll
      for (int ks = 0; ks < 4; ++ks) {
        const float4 s0 = *(const float4*)(X + (16 * mb + c15) * 132 + ks * 32 + quad * 8);
        const float4 s1 = *(const float4*)(X + (16 * mb + c15) * 132 + ks * 32 + quad * 8 + 4);
        uint4 pk; pk.x = pk2(s0.x, s0.y); pk.y = pk2(s0.z, s0.w); pk.z = pk2(s1.x, s1.y); pk.w = pk2(s1.z, s1.w);
        y = mfma16(as_bf(pk), Cf[ks], y);
      }
#pragma unroll
      for (int j = 0; j < 4; ++j) {
        const int t = t0 + 16 * mb + 4 * quad + j;
        float yy = y[j] + dsk * bf2f(Ul[(16 * mb + 4 * quad + j) * 16 + c15]);
        ub[(size_t)t * 512 + c15] = (u16)f2bf(gelu_tanh(yy));
      }
    }
    }
    __builtin_amdgcn_fence(__ATOMIC_RELEASE, "wavefront");
    __builtin_amdgcn_wave_barrier();
    __builtin_amdgcn_fence(__ATOMIC_ACQUIRE, "wavefront");
  }
  if (MODE == 0) Eg[seg * 64 + lane] = make_float2(sr, si);
}


DI void cumsum_item(const Params& p, int bh) {
  const int lane = threadIdx.x & 63;
  const float4* lf = (const float4*)((const float*)(p.ws + OFF_LOGF) + (size_t)bh * 4096 + lane * 64);
  float4* co = (float4*)((float*)(p.ws + OFF_CUM) + (size_t)bh * 4096 + lane * 64);
  float run = 0.f;
  float4 v[16];
#pragma unroll
  for (int i = 0; i < 16; ++i) {
    float4 t = lf[i];
    t.x *= 1.4426950408889634f; t.y *= 1.4426950408889634f; t.z *= 1.4426950408889634f; t.w *= 1.4426950408889634f;
    t.x += run; t.y += t.x; t.z += t.y; t.w += t.z; run = t.w;
    v[i] = t;
  }
  float inc = run;
#pragma unroll
  for (int d = 1; d < 64; d <<= 1) { float t = __shfl_up(inc, d); if (lane >= d) inc += t; }
  const float off = inc - run;
#pragma unroll
  for (int i = 0; i < 16; ++i) { float4 t = v[i]; t.x += off; t.y += off; t.z += off; t.w += off; co[i] = t; }
}


DI void dma16(const void* g, unsigned lds_off) {
  asm volatile("s_mov_b32 m0, %0\n\ts_nop 0\n\tglobal_load_lds_dwordx4 %1, off" :: "s"(__builtin_amdgcn_readfirstlane(lds_off)), "v"(g) : "memory", "m0");
}
DI void dma4(const void* g, unsigned lds_off) {
  asm volatile("s_mov_b32 m0, %0\n\ts_nop 0\n\tglobal_load_lds_dword %1, off" :: "s"(__builtin_amdgcn_readfirstlane(lds_off)), "v"(g) : "memory", "m0");
}

DI void attn_item(const Params& p, int bh, int qb, char* lds) {
  constexpr int OPB = 32 * 256, SB = 2 * OPB;
  const int tid = threadIdx.x, lane = tid & 63, w = tid >> 6, r = lane & 31, hh = lane >> 5;
  float* cumS = (float*)(lds + 4 * SB) + w * 64;
  const int b = bh >> 3, h = bh & 7;
  const size_t tokbase = (size_t)b * 4096;
  const float* cumg = (const float*)(p.ws + OFF_CUM) + (size_t)bh * 4096;
  const int q0 = qb * 128;
  const int myq = q0 + 32 * w + r;
  const u16* Qg = (const u16*)(p.ws + OFF_Q) + (tokbase + myq) * 1024 + h * 128 + hh * 8;
  bf16x8 Qf[8];
#pragma unroll
  for (int s = 0; s < 8; ++s) Qf[s] = as_bf(ld16(Qg + s * 16));
  const float cq = cumg[myq];
  const int nkt = 4 * qb + 4;
  int kt0;
  {
    float gq = fmaxf(fabsf(p.q_g[lane]), fabsf(p.q_g[lane + 64])), gk = fmaxf(fabsf(p.k_g[lane]), fabsf(p.k_g[lane + 64]));
#pragma unroll
    for (int d = 32; d >= 1; d >>= 1) { gq = fmaxf(gq, __shfl_xor(gq, d)); gk = fmaxf(gk, __shfl_xor(gk, d)); }
    const float thr = -(40.f + 2.f * 1.01f * 11.313708499f * 1.4426950408889634f * gq * gk);
    const float c0 = cumg[q0];
    int* kmin = (int*)(lds + LDS_BYTES - 48);
    __syncthreads();
    if (tid == 0) *kmin = 4 * qb;
    __syncthreads();
    for (int t = tid; t < 4 * qb; t += 256)
      if (c0 - cumg[32 * t + 31] >= thr) atomicMin(kmin, t);
    __syncthreads();
    kt0 = *kmin;
  }
  const int lrow = tid >> 4;
  const int gcK = (tid & 15) ^ ((tid >> 4) & 15);
  const int gcV = (tid & 15) ^ (((tid >> 4) & 3) << 1);
  const u16* Kg = (const u16*)(p.ws + OFF_K) + (tokbase + lrow) * 1024 + h * 128 + gcK * 8;
  const u16* Vg = (const u16*)(p.ws + OFF_V) + (tokbase + lrow) * 1024 + h * 128 + gcV * 8;
  const unsigned lds0 = (unsigned)(size_t)lds;
  auto issue = [&](int kt) {
    const unsigned base = lds0 + (kt & 3) * SB + w * 1024;
#pragma unroll
    for (int i = 0; i < 2; ++i) {
      dma16(Kg + (size_t)(kt * 32 + 16 * i) * 1024, base + i * 4096);
      dma16(Vg + (size_t)(kt * 32 + 16 * i) * 1024, base + OPB + i * 4096);
    }
    dma4(cumg + kt * 32 + lane, lds0 + 4 * SB + (w * 64 + (kt & 3) * 256) * 4);
  };
  f32x16 oacc[4];
#pragma unroll
  for (int d = 0; d < 4; ++d)
#pragma unroll
    for (int i = 0; i < 16; ++i) oacc[d][i] = 0.f;
  float mrun = -INFINITY, lsum = 0.f;
  const int i16 = lane & 15, q4 = i16 >> 2, p4 = i16 & 3, blk = (lane >> 4) & 1;
  const int ksw = r & 15;
  asm volatile("s_waitcnt vmcnt(0)" ::: "memory");
  RAW_BARRIER();
  issue(kt0); issue(kt0 + 1); issue(kt0 + 2);
  auto compute = [&](int kt) {
    const char* Kl = lds + (kt & 3) * SB;
    const char* Vl = Kl + OPB;
    const float* cS = cumS + (kt & 3) * 256;
    f32x16 sacc;
#pragma unroll
    for (int ig = 0; ig < 4; ++ig) {
      const float4 ck = *(const float4*)(cS + 8 * ig + 4 * hh);
      sacc[4 * ig] = cq - ck.x; sacc[4 * ig + 1] = cq - ck.y; sacc[4 * ig + 2] = cq - ck.z; sacc[4 * ig + 3] = cq - ck.w;
    }
#pragma unroll
    for (int s = 0; s < 8; ++s) {
      bf16x8 kf = *(const bf16x8*)(Kl + r * 256 + (((2 * s + hh) ^ ksw) * 16));
      sacc = mfma32(kf, Qf[s], sacc);
    }
    if (kt >= 4 * qb) {
#pragma unroll
      for (int i = 0; i < 16; ++i) {
        const int key = kt * 32 + crow(i, hh);
        if (key > myq) sacc[i] = -INFINITY;
      }
    }
    float mx = sacc[0];
#pragma unroll
    for (int i = 1; i < 16; ++i) mx = fmaxf(mx, sacc[i]);
    mx = fmaxf(mx, __shfl_xor(mx, 32));
    if (__builtin_amdgcn_ballot_w64(mx > mrun + 20.f) != 0ull) {
      const float mnew = fmaxf(mrun, mx);
      const float alpha = __builtin_amdgcn_exp2f(mrun - mnew);
      mrun = mnew;
      lsum *= alpha;
#pragma unroll
      for (int d = 0; d < 4; ++d)
#pragma unroll
        for (int i = 0; i < 16; ++i) oacc[d][i] *= alpha;
    }
    float ps = 0.f;
#pragma unroll
    for (int i = 0; i < 16; ++i) {
      float e = __builtin_amdgcn_exp2f(sacc[i] - mrun);
      sacc[i] = e;
      ps += e;
    }
    lsum += ps;
#pragma unroll
    for (int sp = 0; sp < 2; ++sp) {
      uint4 pk;
      pk.x = pk2(sacc[8 * sp], sacc[8 * sp + 1]);
      pk.y = pk2(sacc[8 * sp + 2], sacc[8 * sp + 3]);
      pk.z = pk2(sacc[8 * sp + 4], sacc[8 * sp + 5]);
      pk.w = pk2(sacc[8 * sp + 6], sacc[8 * sp + 7]);
      const bf16x8 pf = as_bf(pk);
      const char* vrow = Vl + (16 * sp + 4 * hh + q4) * 256 + (p4 & 1) * 8;
#pragma unroll
      for (int db = 0; db < 4; ++db) {
        const int po = ((4 * db + 2 * blk + (p4 >> 1)) ^ (q4 << 1)) * 16;
        s16x4 lo = __builtin_amdgcn_ds_read_tr16_b64_v4i16((__attribute__((address_space(3))) s16x4*)(vrow + po));
        s16x4 hi = __builtin_amdgcn_ds_read_tr16_b64_v4i16((__attribute__((address_space(3))) s16x4*)(vrow + 8 * 256 + po));
        bf16x8 vf = __builtin_shufflevector(lo, hi, 0, 1, 2, 3, 4, 5, 6, 7);
        oacc[db] = mfma32(vf, pf, oacc[db]);
      }
    }
  };
  for (int kt = kt0; kt < nkt; ++kt) {
    if (kt + 2 < nkt) asm volatile("s_waitcnt vmcnt(10)" ::: "memory");
    else if (kt + 1 < nkt) asm volatile("s_waitcnt vmcnt(5)" ::: "memory");
    else asm volatile("s_waitcnt vmcnt(0)" ::: "memory");
    RAW_BARRIER();
    if (kt + 3 < nkt) issue(kt + 3);
    compute(kt);
  }
  const float ltot = lsum + __shfl_xor(lsum, 32);
  const float inv = 1.f / ltot;
  const u16* gag = (const u16*)(p.ws + OFF_GA) + (tokbase + myq) * 1024 + h * 128;
  u16* og = (u16*)(p.ws + OFF_Q) + (tokbase + myq) * 1024 + h * 128;
#pragma unroll
  for (int db = 0; db < 4; ++db)
#pragma unroll
    for (int ig = 0; ig < 4; ++ig) {
      const int d = 32 * db + 8 * ig + 4 * hh;
      uint2 ga = *(const uint2*)(gag + d);
      uint2 o;
      o.x = pk2(oacc[db][4 * ig] * inv * bflo(ga.x), oacc[db][4 * ig + 1] * inv * bfhi(ga.x));
      o.y = pk2(oacc[db][4 * ig + 2] * inv * bflo(ga.y), oacc[db][4 * ig + 3] * inv * bfhi(ga.y));
      *(uint2*)(og + d) = o;
    }
}

DI void ins32(unsigned (&L)[16], unsigned k) {
#pragma unroll
  for (int j = 0; j < 16; ++j) {
    unsigned hi = L[j] > k ? L[j] : k;
    k = L[j] > k ? k : L[j];
    L[j] = hi;
  }
}
DI void ins64(u64 (&M)[16], u64 k) {
#pragma unroll
  for (int j = 0; j < 16; ++j) {
    const bool gt = k > M[j];
    const u64 hi = gt ? k : M[j];
    const u64 lo = gt ? M[j] : k;
    M[j] = hi;
    k = lo;
  }
}


DI void cex_desc(unsigned& a, unsigned& b) { const unsigned hi = a > b ? a : b, lo = a > b ? b : a; a = hi; b = lo; }
DI void bitonic_sort16_desc(unsigned (&v)[16]) {
#pragma unroll
  for (int k = 2; k <= 16; k <<= 1)
#pragma unroll
    for (int j = k >> 1; j >= 1; j >>= 1)
#pragma unroll
      for (int i = 0; i < 16; ++i) {
        const int l = i ^ j;
        if (l > i) {
          if ((i & k) == 0) cex_desc(v[i], v[l]);
          else cex_desc(v[l], v[i]);
        }
      }
}
DI void merge_top16_desc(unsigned (&a)[16], const unsigned (&b)[16]) {
#pragma unroll
  for (int i = 0; i < 16; ++i) a[i] = a[i] > b[15 - i] ? a[i] : b[15 - i];
#pragma unroll
  for (int j = 8; j >= 1; j >>= 1)
#pragma unroll
    for (int i = 0; i < 16; ++i) {
      const int l = i ^ j;
      if (l > i) cex_desc(a[i], a[l]);
    }
}

DI void route_item(const Params& p, int tt, int h, const char* skl) {
  const int lane = threadIdx.x & 63, r = lane & 31, hh = lane >> 5;
  const int tok = tt * 32 + r;
  const u16* pq = (const u16*)(p.ws + OFF_V) + (size_t)tok * 2048 + h * 256 + hh * 8;
  uint4 bqv[16];
#pragma unroll
  for (int i = 0; i < 16; ++i) bqv[i] = ld16(pq + (i >> 3) * 128 + (i & 7) * 16);
  const char* skr = skl + r * 256;
  const int ksw = r & 15;
  unsigned L[2][16];
  const unsigned hsel = (unsigned)hh << 2;
#pragma unroll
  for (int c = 0; c < 2; ++c) {
    f32x16 acc[4];
#pragma unroll
    for (int kb = 0; kb < 4; ++kb)
#pragma unroll
      for (int i = 0; i < 16; ++i) acc[kb][i] = 0.f;
#pragma unroll
    for (int s = 0; s < 8; ++s) {
      const bf16x8 bq = as_bf(bqv[c * 8 + s]);
#pragma unroll
      for (int kb = 0; kb < 4; ++kb) {
        const bf16x8 ak = *(const bf16x8*)(skr + (c * 128 + kb * 32) * 256 + (((2 * s + hh) ^ ksw) * 16));
        acc[kb] = mfma32(ak, bq, acc[kb]);
      }
      __builtin_amdgcn_sched_barrier(0);
    }
#pragma unroll
    for (int kb = 0; kb < 4; ++kb) {
      unsigned G[16];
#pragma unroll
      for (int i = 0; i < 16; ++i) G[i] = (srt(acc[kb][i]) & ~127u) | (unsigned)(127 - (32 * kb + crow(i, 0)));
      bitonic_sort16_desc(G);
      if (kb == 0) {
#pragma unroll
        for (int i = 0; i < 16; ++i) L[c][i] = G[i];
      } else {
        merge_top16_desc(L[c], G);
      }
      __builtin_amdgcn_sched_barrier(0);
    }
    unsigned P[16];
#pragma unroll
    for (int j = 0; j < 16; ++j) { L[c][j] ^= hsel; P[j] = (unsigned)__shfl_xor((int)L[c][j], 32); }
    merge_top16_desc(L[c], P);
  }
  float s0[16], s1[16];
  unsigned W0[4] = {0u, 0u, 0u, 0u}, W1[4] = {0u, 0u, 0u, 0u};
#pragma unroll
  for (int j = 0; j < 16; ++j) {
    s0[j] = unsrt(L[0][j] & ~127u);
    s1[j] = unsrt(L[1][j] & ~127u);
    W0[j >> 2] |= (127u - (L[0][j] & 127u)) << (8 * (j & 3));
    W1[j >> 2] |= (127u - (L[1][j] & 127u)) << (8 * (j & 3));
  }
  unsigned M[16];
  {
    unsigned C[64];
    int n = 0;
#pragma unroll
    for (int i = 0; i < 16; ++i)
#pragma unroll
      for (int j = 0; j < 16; ++j)
        if ((i + 1) * (j + 1) <= 16) {
          const float s = s0[i] + s1[j];
          C[n++] = (srt(s) & ~255u) | (unsigned)(255 - (i * 16 + j));
        }
#pragma unroll
    for (int k = 50; k < 64; ++k) C[k] = 0u;
#pragma unroll
    for (int gi = 0; gi < 4; ++gi) {
      unsigned G[16];
#pragma unroll
      for (int i = 0; i < 16; ++i) G[i] = C[gi * 16 + i];
      bitonic_sort16_desc(G);
      if (gi == 0) {
#pragma unroll
        for (int i = 0; i < 16; ++i) M[i] = G[i];
      } else {
        merge_top16_desc(M, G);
      }
      __builtin_amdgcn_sched_barrier(0);
    }
  }
  float bs[16], den = 0.f;
  unsigned eidx[16];
  const float top = unsrt(M[0] & ~255u);
#pragma unroll
  for (int j = 0; j < 16; ++j) {
    bs[j] = __expf(unsrt(M[j] & ~255u) - top);
    den += bs[j];
    const unsigned code = 255u - (M[j] & 255u);
    const unsigned ci = code >> 4, cj = code & 15u;
    const unsigned wi = ci < 8 ? (ci < 4 ? W0[0] : W0[1]) : (ci < 12 ? W0[2] : W0[3]);
    const unsigned wj = cj < 8 ? (cj < 4 ? W1[0] : W1[1]) : (cj < 12 ? W1[2] : W1[3]);
    eidx[j] = ((wi >> (8 * (ci & 3))) & 127u) * 128u + ((wj >> (8 * (cj & 3))) & 127u);
  }
  const float inv = 1.f / den;
  if (hh == 0) {
    uint4* rt = (uint4*)(p.ws + OFF_GA) + ((size_t)tok * 8 + h) * 8;
#pragma unroll
    for (int j = 0; j < 8; ++j) {
      uint4 o;
      o.x = eidx[2 * j]; o.y = __float_as_uint(bs[2 * j] * inv);
      o.z = eidx[2 * j + 1]; o.w = __float_as_uint(bs[2 * j + 1] * inv);
      rt[j] = o;
    }
  }
}

template <int VAR>
DI void expert_token(const Params& p, int tok, char* ldsw) {
  const int lane = threadIdx.x & 63, c15 = lane & 15, quad = lane >> 4;
  const unsigned char* Ub = (const unsigned char*)(p.ws + OFF_UBF);
  const unsigned char* Vb = (const unsigned char*)(p.ws + OFF_VBF);
  const uint2* rt = (const uint2*)(p.ws + OFF_GA) + (size_t)tok * 128;
  const u16* h2 = (const u16*)(p.ws + OFF_K) + (size_t)tok * 1024;
  uint2 re = rt[c15];
  const uint4 h2a = ld16(h2 + lane * 16), h2b = ld16(h2 + lane * 16 + 8);
  float o[16];
#pragma unroll
  for (int i = 0; i < 16; ++i) o[i] = 0.f;
  uint4 ub[16];
  if (VAR != 2) {
    const unsigned char* urow = Ub + (size_t)re.x * 1024 + quad * 16;
#pragma unroll
    for (int kd = 0; kd < 16; ++kd) ub[kd] = ld16(urow + kd * 64);
  }
  __builtin_amdgcn_sched_barrier(0);
  *(uint4*)(ldsw + lane * 32) = h2a;
  *(uint4*)(ldsw + lane * 32 + 16) = h2b;
  __builtin_amdgcn_fence(__ATOMIC_RELEASE, "wavefront");
  __builtin_amdgcn_wave_barrier();
  __builtin_amdgcn_fence(__ATOMIC_ACQUIRE, "wavefront");
#pragma unroll 1
  for (int hd = 0; hd < 8; ++hd) {
    const int e = (int)re.x;
    const float g = __uint_as_float(re.y);
    uint4 vb[16];
    if (VAR != 1) {
#pragma unroll
      for (int j = 0; j < 16; ++j) vb[j] = ld16(Vb + (size_t)__builtin_amdgcn_readlane(e, j) * 1024 + lane * 16);
    }
    __builtin_amdgcn_sched_barrier(0);
    f32x4 acc = {0.f, 0.f, 0.f, 0.f};
    if (VAR != 2)
#pragma unroll
    for (int kd = 0; kd < 16; ++kd) {
      const uint4 bq = ub[kd];
      const bf16x8 a0 = *(const bf16x8*)(ldsw + (kd * 64 + quad * 16) * 2);
      const bf16x8 a1 = *(const bf16x8*)(ldsw + (kd * 64 + quad * 16) * 2 + 16);
      const uint2 b0l = fp8x4_to_bf16x4(bq.x), b0h = fp8x4_to_bf16x4(bq.y), b1l = fp8x4_to_bf16x4(bq.z), b1h = fp8x4_to_bf16x4(bq.w);
      uint4 b0, b1;
      b0.x = b0l.x; b0.y = b0l.y; b0.z = b0h.x; b0.w = b0h.y;
      b1.x = b1l.x; b1.y = b1l.y; b1.z = b1h.x; b1.w = b1h.y;
      acc = mfma16(a0, as_bf(b0), acc);
      acc = mfma16(a1, as_bf(b1), acc);
    }
    const float wgt = g * gelu_tanh(acc[0] * (1.f / U_SCALE)) * (1.f / V_SCALE);
    if (hd + 1 < 8) {
      re = rt[(hd + 1) * 16 + c15];
      if (VAR != 2) {
        const unsigned char* urow = Ub + (size_t)re.x * 1024 + quad * 16;
#pragma unroll
        for (int kd = 0; kd < 16; ++kd) ub[kd] = ld16(urow + kd * 64);
      }
    }
    __builtin_amdgcn_sched_barrier(0);
    if (VAR == 1) { o[hd] += wgt; continue; }
#pragma unroll
    for (int j = 0; j < 16; ++j) {
      const float wj = __uint_as_float(__builtin_amdgcn_readlane(__float_as_uint(wgt), j));
      const uint4 v = vb[j];
      f32x2 t;
      t = __builtin_amdgcn_cvt_pk_f32_fp8((int)v.x, false); o[0] += wj * t[0]; o[1] += wj * t[1];
      t = __builtin_amdgcn_cvt_pk_f32_fp8((int)v.x, true);  o[2] += wj * t[0]; o[3] += wj * t[1];
      t = __builtin_amdgcn_cvt_pk_f32_fp8((int)v.y, false); o[4] += wj * t[0]; o[5] += wj * t[1];
      t = __builtin_amdgcn_cvt_pk_f32_fp8((int)v.y, true);  o[6] += wj * t[0]; o[7] += wj * t[1];
      t = __builtin_amdgcn_cvt_pk_f32_fp8((int)v.z, false); o[8] += wj * t[0]; o[9] += wj * t[1];
      t = __builtin_amdgcn_cvt_pk_f32_fp8((int)v.z, true);  o[10] += wj * t[0]; o[11] += wj * t[1];
      t = __builtin_amdgcn_cvt_pk_f32_fp8((int)v.w, false); o[12] += wj * t[0]; o[13] += wj * t[1];
      t = __builtin_amdgcn_cvt_pk_f32_fp8((int)v.w, true);  o[14] += wj * t[0]; o[15] += wj * t[1];
      __builtin_amdgcn_sched_barrier(0);
    }
  }
  if (VAR != 0) {
    float sacc_ = 0.f;
#pragma unroll
    for (int i = 0; i < 16; ++i) sacc_ += o[i];
    if (sacc_ == 12345.678f) ((float*)(p.ws + OFF_CUM))[lane] = sacc_;
    return;
  }
  float4* out = (float4*)(p.out + (size_t)tok * 1024 + lane * 16);
  float4 x0 = out[0], x1 = out[1], x2 = out[2], x3 = out[3];
  x0.x += o[0]; x0.y += o[1]; x0.z += o[2]; x0.w += o[3];
  x1.x += o[4]; x1.y += o[5]; x1.z += o[6]; x1.w += o[7];
  x2.x += o[8]; x2.y += o[9]; x2.z += o[10]; x2.w += o[11];
  x3.x += o[12]; x3.y += o[13]; x3.z += o[14]; x3.w += o[15];
  out[0] = x0; out[1] = x1; out[2] = x2; out[3] = x3;
  __builtin_amdgcn_fence(__ATOMIC_RELEASE, "wavefront");
  __builtin_amdgcn_wave_barrier();
  __builtin_amdgcn_fence(__ATOMIC_ACQUIRE, "wavefront");
}

template <class F>
DI void walk_tiles(int NT, int nw, F&& f) {
  const int x = blockIdx.x & 7, j = blockIdx.x >> 3, nloc = gridDim.x >> 3;
  const int mpc = 64 / nw;
  const int ngr = (NT + nw - 1) / nw, mgr = 32 / mpc;
  for (int c = 0; c < mgr * ngr; ++c) {
    const int mg = c / ngr, ng = c % ngr;
    for (int u = j; u < 64; u += nloc) {
      const int mt = 32 * x + mg * mpc + (u % mpc), nt = ng * nw + u / mpc;
      if (nt < NT) f(mt, nt);
    }
  }
}

#define XB_TMO      128
#define XB_XCNT(j)  (256  + 64 * (j))
#define XB_XSUB(j)  (1280 + 64 * (j))
#define XB_XGEN(j)  (2304 + 64 * (j))
#define XB_TOP      3328
#define XB_TOPGEN   3392
#define XCD_BAR_WORDS 3456
#define XB_SPIN_CAP (1u << 22)
#define LAS __attribute__((address_space(3)))
DI unsigned xb_ld(unsigned* p) { return __hip_atomic_load(p, __ATOMIC_RELAXED, __HIP_MEMORY_SCOPE_AGENT); }
DI unsigned xb_add(unsigned* p, unsigned v) { return __hip_atomic_fetch_add(p, v, __ATOMIC_RELAXED, __HIP_MEMORY_SCOPE_AGENT); }
DI unsigned xb_xcc_id() { return (unsigned)__builtin_amdgcn_s_getreg((3 << 11) | 20) & 0xFu; }
#define XB_SPIN(cond, bar) do { unsigned _sp = 0; while (cond) { __builtin_amdgcn_s_sleep(1); \
    if ((++_sp & 255u) == 0u) { if (xb_ld(&(bar)[XB_TMO])) break; if (_sp > XB_SPIN_CAP) { atomicAdd(&(bar)[XB_TMO], 1u); break; } } } } while (0)
struct XcdBarrier { unsigned* bar; unsigned x; volatile LAS unsigned* st; };
DI XcdBarrier xcd_barrier_post(unsigned* bar, volatile LAS unsigned* st) {
  XcdBarrier b; b.bar = bar; b.x = xb_xcc_id(); b.st = st;
  if (threadIdx.x == 0) (void)xb_add(&bar[XB_XCNT(b.x)], 1u);
  return b;
}
DI void xcd_barrier_complete(unsigned* bar, unsigned x, unsigned& nloc, unsigned& nx) {
  const unsigned G = gridDim.x * gridDim.y * gridDim.z;
  unsigned sum, cnt, mine, sp = 0u;
  for (;;) {
    sum = 0u; cnt = 0u; mine = 0u;
#pragma unroll
    for (unsigned j = 0; j < 16; ++j) { const unsigned c = xb_ld(&bar[XB_XCNT(j)]); sum += c; cnt += (c > 0u) ? 1u : 0u; mine = (j == x) ? c : mine; }
    if (sum == G) break;
    __builtin_amdgcn_s_sleep(1);
    if ((++sp & 255u) == 0u) { if (xb_ld(&bar[XB_TMO])) break; if (sp > XB_SPIN_CAP) { atomicAdd(&bar[XB_TMO], 1u); break; } }
  }
  nloc = mine > 0u ? mine : 1u; nx = cnt > 0u ? cnt : 1u;
}
DI void xcd_barrier(const XcdBarrier& b) {
  asm volatile("s_waitcnt vmcnt(0)" ::: "memory");
  __syncthreads();
  if (threadIdx.x == 0) {
    unsigned* bar = b.bar;
    __builtin_amdgcn_s_waitcnt(0);
    unsigned nloc = b.st[0], nx = b.st[1];
    if (nloc == 0u) { xcd_barrier_complete(bar, b.x, nloc, nx); b.st[0] = nloc; b.st[1] = nx; }
    const unsigned old = xb_add(&bar[XB_XSUB(b.x)], 1u);
    const unsigned gen = old / nloc;
    if (old + 1u == (gen + 1u) * nloc) {
      __builtin_amdgcn_fence(__ATOMIC_RELEASE, "agent");
      asm volatile("s_waitcnt vmcnt(0)" ::: "memory");
      const unsigned og = xb_add(&bar[XB_TOP], 1u);
      const unsigned tg = og / nx;
      if (og + 1u == (tg + 1u) * nx) xb_add(&bar[XB_TOPGEN], 1u);
      else XB_SPIN(xb_ld(&bar[XB_TOPGEN]) == tg, bar);
      __builtin_amdgcn_fence(__ATOMIC_ACQUIRE, "agent");
      xb_add(&bar[XB_XGEN(b.x)], 1u);
      asm volatile("s_waitcnt vmcnt(0)" ::: "memory");
    } else {
      XB_SPIN(xb_ld(&bar[XB_XGEN(b.x)]) == gen, bar);
      __builtin_amdgcn_fence(__ATOMIC_ACQUIRE, "agent");
      asm volatile("s_waitcnt vmcnt(0)" ::: "memory");
    }
  }
  __syncthreads();
}

template <int PH>
DI void run_phase(const Params& p, char* lds) {
  const int tid = threadIdx.x, w = tid >> 6;
  if (PH == 0) {
    phase_prep(p, lds);
  } else if (PH == 1) {
    {
      const int x = blockIdx.x & 7, j = blockIdx.x >> 3, nloc = gridDim.x >> 3;
      for (int c = 0; c < 11; ++c)
        for (int u = j; u < 64; u += nloc) {
          int mt, nt;
          if (c < 10) { mt = 32 * x + 16 * (c / 5) + (u & 15); nt = 4 * (c % 5) + (u >> 4); }
          else { mt = 32 * x + (u & 31); nt = 20 + (u >> 5); }
          gemm_tile<1024, G_INPROJ>(p, (const u16*)(p.ws + OFF_H), (const u16*)(p.ws + OFF_WIN), mt, nt, lds);
        }
    }
  } else if (PH == 2 || PH == 12 || PH == 13) {
    int* ctr = (int*)(p.ws + OFF_CTR) + (blockIdx.x & 7) + (PH == 2 ? 0 : 8);
    const int x = blockIdx.x & 7;
    int* s_item = (int*)(lds + LDS_BYTES - 16);
    for (;;) {
      __syncthreads();
      if (tid == 0) *s_item = atomicAdd(ctr, 1);
      __syncthreads();
      const int it = *s_item;
      if (it >= 32 + 256) break;
      if (it < 32) {
        if (PH != 13) s5_item<1>(p, x * 32 + it, w, lds + w * 17920);
      } else {
        const int a = it - 32;
        attn_item(p, x * 8 + (a & 7), 31 - (a >> 3), lds);
      }
    }
  } else if (PH == 3) {
    walk_tiles(8, 8, [&](int mt, int nt) {
      gemm_tile<512, G_GLU>(p, (const u16*)(p.ws + OFF_U), (const u16*)(p.ws + OFF_WGLU), mt, nt, lds);
    });
  } else if (PH == 4) {
    walk_tiles(4, 4, [&](int mt, int nt) {
      gemm_tile<1024, G_OUT>(p, (const u16*)(p.ws + OFF_H), (const u16*)(p.ws + OFF_WOUT), mt, nt, lds);
    });
  } else if (PH == 5) {
    rmsnorm_rows_t<false>(p, p.out, p.ffn_g, (u16*)(p.ws + OFF_K));
  } else if (PH == 6) {
    walk_tiles(8, 8, [&](int mt, int nt) {
      gemm_tile<1024, G_PQ>(p, (const u16*)(p.ws + OFF_K), (const u16*)(p.ws + OFF_WQ), mt, nt, lds);
    });
  } else if (PH == 7) {
    const int gw = blockIdx.x * 4 + w, nw = gridDim.x * 4;
    {
      const int h = blockIdx.x & 7, jb = blockIdx.x >> 3, nloc = gridDim.x >> 3;
      const u16* skg = (const u16*)(p.ws + OFF_SK) + (size_t)h * 256 * 128;
#pragma unroll 4
      for (int i = 0; i < 16; ++i) {
        const int ci = tid + 256 * i, row = ci >> 4, pc = ci & 15, gc = pc ^ (row & 15);
        *(uint4*)(lds + row * 256 + pc * 16) = ld16(skg + row * 128 + gc * 8);
      }
      __syncthreads();
      for (int tt = jb * 4 + w; tt < 1024; tt += nloc * 4) route_item(p, tt, h, lds);
      __syncthreads();
    }
    {
      const size_t nthr = (size_t)gridDim.x * 256, gtid = (size_t)blockIdx.x * 256 + tid;
      cvt_rows_fp8(p.peer_u, (unsigned char*)(p.ws + OFF_UBF), 16384ull * 1024 / 16, U_SCALE, gtid, nthr);
      cvt_rows_fp8(p.peer_v, (unsigned char*)(p.ws + OFF_VBF), 16384ull * 1024 / 16, V_SCALE, gtid, nthr);
    }
  } else if (PH == 8) {
    const int gw = blockIdx.x * 4 + w, nw = gridDim.x * 4;
    for (int tok = gw; tok < NTOK; tok += nw) expert_token<0>(p, tok, lds + w * 2048);
  } else if (PH == 14) {
    const int gw = blockIdx.x * 4 + w, nw = gridDim.x * 4;
    for (int tok = gw; tok < NTOK; tok += nw) expert_token<1>(p, tok, lds + w * 2048);
  } else if (PH == 15) {
    const int gw = blockIdx.x * 4 + w, nw = gridDim.x * 4;
    for (int tok = gw; tok < NTOK; tok += nw) expert_token<2>(p, tok, lds + w * 2048);
  } else if (PH == 9) {
    const int gw = blockIdx.x * 4 + w;
    if (gw < 64) cumsum_item(p, gw);
    const int nw9 = gridDim.x * 4;
    for (int it = nw9 - 1 - gw; it < 768; it += nw9) s5_item<0>(p, it / 3, it % 3, lds + w * 17920);
    qknorm_rows(p);
  }
}

template <int MODE>
__global__ __launch_bounds__(256, 2) void mk(Params p) {
  extern __shared__ __attribute__((aligned(16))) char lds[];
  if (MODE >= 0) {
    run_phase<MODE>(p, lds);
  } else {
    cg::grid_group grid = cg::this_grid();
    volatile LAS unsigned* st = (volatile LAS unsigned*)(lds + LDS_BYTES - 32);
    if (threadIdx.x == 0) { st[0] = 0u; st[1] = 0u; }
    __syncthreads();
    const XcdBarrier xb = xcd_barrier_post((unsigned*)(p.ws + OFF_BAR), st);
    if (p.out == nullptr) grid.sync();
    run_phase<0>(p, lds); xcd_barrier(xb);
    run_phase<1>(p, lds); xcd_barrier(xb);
    run_phase<9>(p, lds); xcd_barrier(xb);
    run_phase<2>(p, lds); xcd_barrier(xb);
    run_phase<3>(p, lds); xcd_barrier(xb);
    run_phase<4>(p, lds); xcd_barrier(xb);
    run_phase<5>(p, lds); xcd_barrier(xb);
    run_phase<6>(p, lds); xcd_barrier(xb);
    run_phase<7>(p, lds); xcd_barrier(xb);
    run_phase<8>(p, lds);
#ifdef EXPF
#if EXPF == 1
    for (int i = 0; i < 10; ++i) grid.sync();
#elif EXPF == 2
    grid.sync(); run_phase<1>(p, lds);
#endif
#endif
  }
}


template <int D>
__global__ void mk_dump(Params p) {
  const size_t n = (size_t)NTOK * 1024;
  for (size_t i = (size_t)blockIdx.x * 256 + threadIdx.x; i < n; i += (size_t)gridDim.x * 256) {
    const size_t tok = i >> 10, c = i & 1023;
    float v = 0.f;
    if (D == 1) {
#if DUMPSUB == 0
      v = bf2f(((const u16*)(p.ws + OFF_U))[tok * 512 + (c & 511)]);
#elif DUMPSUB == 1
      v = bf2f(((const u16*)(p.ws + OFF_V))[i]) + bf2f(((const u16*)(p.ws + OFF_GS))[i]) + bf2f(((const u16*)(p.ws + OFF_GA))[i]);
#elif DUMPSUB == 2
      v = bf2f(((const u16*)(p.ws + OFF_Q))[i]) + bf2f(((const u16*)(p.ws + OFF_K))[i]);
#else
      v = ((const float*)(p.ws + OFF_LOGF))[i & 262143];
#endif
    } else if (D == 11) {
      v = bf2f(((const u16*)(p.ws + OFF_Q))[i]) + bf2f(((const u16*)(p.ws + OFF_K))[i]) + bf2f(((const u16*)(p.ws + OFF_V))[i]) +
          bf2f(((const u16*)(p.ws + OFF_GS))[i]) + bf2f(((const u16*)(p.ws + OFF_GA))[i]) + bf2f(((const u16*)(p.ws + OFF_U))[tok * 512 + (c & 511)]) +
          ((const float*)(p.ws + OFF_LOGF))[i & 262143];
    } else if (D == 2) {
      v = bf2f(((const u16*)(p.ws + OFF_Q))[i]);
    } else if (D == 3) {
      v = bf2f(((const u16*)(p.ws + OFF_U))[tok * 512 + (c & 511)]);
    } else if (D == 4) {
      v = bf2f(((const u16*)(p.ws + OFF_H))[i]);
    } else if (D == 5) {
      v = bf2f(((const u16*)(p.ws + OFF_H))[i]) + bf2f(((const u16*)(p.ws + OFF_WIN))[i % (5760 * 1024)]) + bf2f(((const u16*)(p.ws + OFF_WQ))[i & (2048 * 1024 - 1)]);
    }
    p.out[i] = v;
  }
}

extern "C" void kernel_launch(void* const* d_in, const int* in_sizes, int n_in, void* d_out, int out_size, void* d_ws,
                              size_t ws_size, hipStream_t stream) {
  if (ws_size < WS_NEED) { fprintf(stderr, "workspace too small: %zu < %zu\n", ws_size, (size_t)WS_NEED); return; }
  Params p{};
  const float** f = (const float**)&p;
  for (int i = 0; i < 21; ++i) f[i] = (const float*)d_in[i];
  p.out = (float*)d_out;
  p.ws = (char*)d_ws;
#if FUSED
  static int grid_blocks = 0;
  if (!grid_blocks) {
    int dev = 0, cus = 0, per_cu = 0;
    hipGetDevice(&dev);
    hipDeviceGetAttribute(&cus, hipDeviceAttributeMultiprocessorCount, dev);
    hipFuncSetAttribute((const void*)mk<-1>, hipFuncAttributeMaxDynamicSharedMemorySize, LDS_BYTES);
    hipOccupancyMaxActiveBlocksPerMultiprocessor(&per_cu, mk<-1>, 256, LDS_BYTES);
    if (per_cu > 2) per_cu = 2;
    grid_blocks = cus * per_cu;
  }
  hipMemsetAsync((char*)d_ws + OFF_BAR, 0, XCD_BAR_WORDS * 4, stream);
  void* args[] = {&p};
  hipError_t e = hipLaunchCooperativeKernel((void*)mk<-1>, dim3(grid_blocks), dim3(256), args, LDS_BYTES, stream);
  if (e != hipSuccess) fprintf(stderr, "cooperative launch failed: %s (grid %d)\n", hipGetErrorString(e), grid_blocks);
#else
  const int G = 512;
  static bool attr_done = false;
  if (!attr_done) {
    hipFuncSetAttribute((const void*)mk<0>, hipFuncAttributeMaxDynamicSharedMemorySize, LDS_BYTES);
    hipFuncSetAttribute((const void*)mk<1>, hipFuncAttributeMaxDynamicSharedMemorySize, LDS_BYTES);
    hipFuncSetAttribute((const void*)mk<2>, hipFuncAttributeMaxDynamicSharedMemorySize, LDS_BYTES);
    hipFuncSetAttribute((const void*)mk<3>, hipFuncAttributeMaxDynamicSharedMemorySize, LDS_BYTES);
    hipFuncSetAttribute((const void*)mk<4>, hipFuncAttributeMaxDynamicSharedMemorySize, LDS_BYTES);
    hipFuncSetAttribute((const void*)mk<5>, hipFuncAttributeMaxDynamicSharedMemorySize, LDS_BYTES);
    hipFuncSetAttribute((const void*)mk<6>, hipFuncAttributeMaxDynamicSharedMemorySize, LDS_BYTES);
    hipFuncSetAttribute((const void*)mk<7>, hipFuncAttributeMaxDynamicSharedMemorySize, LDS_BYTES);
    hipFuncSetAttribute((const void*)mk<8>, hipFuncAttributeMaxDynamicSharedMemorySize, LDS_BYTES);
    hipFuncSetAttribute((const void*)mk<9>, hipFuncAttributeMaxDynamicSharedMemorySize, LDS_BYTES);
    hipFuncSetAttribute((const void*)mk<12>, hipFuncAttributeMaxDynamicSharedMemorySize, LDS_BYTES);
    hipFuncSetAttribute((const void*)mk<14>, hipFuncAttributeMaxDynamicSharedMemorySize, LDS_BYTES);
    hipFuncSetAttribute((const void*)mk<15>, hipFuncAttributeMaxDynamicSharedMemorySize, LDS_BYTES);
    hipFuncSetAttribute((const void*)mk<13>, hipFuncAttributeMaxDynamicSharedMemorySize, LDS_BYTES);
    attr_done = true;
  }
  mk<0><<<G, 256, LDS_BYTES, stream>>>(p);
#ifdef DUMP
#if DUMP == 5
  mk_dump<5><<<1024, 256, 0, stream>>>(p); return;
#endif
#endif
  mk<1><<<G, 256, LDS_BYTES, stream>>>(p);
  mk<9><<<G, 256, LDS_BYTES, stream>>>(p);
#ifdef DUMP
#if DUMP == 1
  mk_dump<1><<<1024, 256, 0, stream>>>(p); return;
#endif
#endif
  mk<2><<<G, 256, LDS_BYTES, stream>>>(p);
#ifdef DUMP
#if DUMP == 2
  mk_dump<2><<<1024, 256, 0, stream>>>(p); return;
#elif DUMP == 3
  mk_dump<3><<<1024, 256, 0, stream>>>(p); return;
#endif
#endif
  mk<3><<<G, 256, LDS_BYTES, stream>>>(p);
#ifdef DUMP
#if DUMP == 4
  mk_dump<4><<<1024, 256, 0, stream>>>(p); return;
#endif
#endif
  mk<4><<<G, 256, LDS_BYTES, stream>>>(p);
#ifndef LASTPH
#define LASTPH 8
#endif
#if LASTPH >= 5
  mk<5><<<G, 256, LDS_BYTES, stream>>>(p);
  mk<6><<<G, 256, LDS_BYTES, stream>>>(p);
  mk<7><<<G, 256, LDS_BYTES, stream>>>(p);
#endif
#if LASTPH >= 8
  mk<8><<<G, 256, LDS_BYTES, stream>>>(p);
#endif
#ifdef EXP
#if EXP == 1
  mk<4><<<G, 256, LDS_BYTES, stream>>>(p);
  mk<8><<<G, 256, LDS_BYTES, stream>>>(p);
#elif EXP == 2
  mk<1><<<G, 256, LDS_BYTES, stream>>>(p);
#elif EXP == 14
  mk<14><<<G, 256, LDS_BYTES, stream>>>(p);
#elif EXP == 15
  mk<15><<<G, 256, LDS_BYTES, stream>>>(p);
#elif EXP == 7
  mk<12><<<G, 256, LDS_BYTES, stream>>>(p);
#elif EXP == 8
  mk<13><<<G, 256, LDS_BYTES, stream>>>(p);
#elif EXP == 5
  mk<7><<<G, 256, LDS_BYTES, stream>>>(p);
#elif EXP == 6
  mk<0><<<G, 256, LDS_BYTES, stream>>>(p);
#elif EXP == 3
  mk<3><<<G, 256, LDS_BYTES, stream>>>(p);
  mk<6><<<G, 256, LDS_BYTES, stream>>>(p);
  mk<7><<<G, 256, LDS_BYTES, stream>>>(p);
#endif
#endif
#endif
}
```

```cpp
#include <hip/hip_runtime.h>
#include <hip/hip_cooperative_groups.h>
#include <stdint.h>
#include <cstdio>
namespace cg = cooperative_groups;

#ifndef FUSED
#define FUSED 1
#define LASTPH 8

#define DUMPSUB 0
#endif

#define DI __device__ __forceinline__
typedef unsigned short u16;
typedef unsigned long long u64;
using bf16x8 = __attribute__((ext_vector_type(8))) short;
using s16x4 = __attribute__((ext_vector_type(4))) short;
using f32x16 = __attribute__((ext_vector_type(16))) float;
using f32x4 = __attribute__((ext_vector_type(4))) float;

constexpr int NTOK = 32768;
constexpr float EPS = 1e-6f;

constexpr size_t MB64 = 67108864ull;
constexpr size_t OFF_WIN = 0;
constexpr size_t OFF_WGLU = OFF_WIN + 5888ull * 1024 * 2;
constexpr size_t OFF_WOUT = OFF_WGLU + 2048ull * 512 * 2;
constexpr size_t OFF_WQ = OFF_WOUT + 1024ull * 1024 * 2;
constexpr size_t OFF_SK = OFF_WQ + 2048ull * 1024 * 2;
constexpr size_t OFF_UBF = OFF_SK + 8ull * 2 * 128 * 128 * 2;
constexpr size_t OFF_VBF = OFF_UBF + 16384ull * 1024 * 2;
constexpr size_t OFF_H = OFF_VBF + 16384ull * 1024 * 2;
constexpr size_t OFF_U = OFF_H + MB64;
constexpr size_t OFF_Q = OFF_U + MB64 / 2;
constexpr size_t OFF_K = OFF_Q + MB64;
constexpr size_t OFF_V = OFF_K + MB64;
constexpr size_t OFF_GS = OFF_V + MB64;
constexpr size_t OFF_GA = OFF_GS + MB64;
constexpr size_t OFF_LOGF = OFF_GA + MB64;
constexpr size_t OFF_CUM = OFF_LOGF + 1048576;
constexpr size_t OFF_LAM = OFF_CUM + 1048576;
constexpr size_t OFF_BB = OFF_LAM + 16384;
constexpr size_t OFF_CM = OFF_BB + 131072;
constexpr size_t OFF_CTR = OFF_CM + 131072;
constexpr size_t OFF_BAR = OFF_CTR + 256;
constexpr size_t OFF_E = OFF_BAR + 16384;
constexpr size_t WS_NEED = OFF_E + 524288;

struct Params {
  const float *x, *mix_g, *w_in, *a_re, *a_im, *log_step, *b_re, *b_im, *c_re, *c_im, *ssm_d, *w_glu,
      *f_bias, *q_g, *k_g, *w_out, *ffn_g, *w_query, *sub_keys, *peer_u, *peer_v;
  float* out;
  char* ws;
};

constexpr int LDS_BYTES = 74752;

typedef __bf16 bf16v2 __attribute__((ext_vector_type(2)));
DI unsigned f2bf(float x) { return (unsigned)__builtin_bit_cast(unsigned short, (__bf16)x); }
DI unsigned pk2(float a, float b) { bf16v2 v = {(__bf16)a, (__bf16)b}; return __builtin_bit_cast(unsigned, v); }
DI float bflo(unsigned u) { return __uint_as_float(u << 16); }
DI float bfhi(unsigned u) { return __uint_as_float(u & 0xffff0000u); }
DI float bf2f(u16 b) { return __uint_as_float(((unsigned)b) << 16); }
DI f32x16 mfma32(bf16x8 a, bf16x8 b, f32x16 c) { return __builtin_amdgcn_mfma_f32_32x32x16_bf16(a, b, c, 0, 0, 0); }
DI f32x4 mfma16(bf16x8 a, bf16x8 b, f32x4 c) { return __builtin_amdgcn_mfma_f32_16x16x32_bf16(a, b, c, 0, 0, 0); }
DI float sigmoidf_(float x) { return __builtin_amdgcn_rcpf(1.f + __expf(-x)); }
DI float gelu_tanh(float x) {
  float z = 0.7978845608028654f * (x + 0.044715f * x * x * x);
  float t = 1.f - 2.f * __builtin_amdgcn_rcpf(__expf(2.f * z) + 1.f);
  return 0.5f * x * (1.f + t);
}
DI float log_sigmoid(float z) { return fminf(z, 0.f) - log1pf(__expf(-fabsf(z))); }
DI int crow(int i, int hh) { return (i & 3) + 8 * (i >> 2) + 4 * hh; }
DI uint4 ld16(const void* p) { return *(const uint4*)p; }
DI bf16x8 as_bf(uint4 v) { return __builtin_bit_cast(bf16x8, v); }
DI uint4 add_bf8(uint4 a, uint4 b) {
  uint4 o;
  o.x = pk2(bflo(a.x) + bflo(b.x), bfhi(a.x) + bfhi(b.x));
  o.y = pk2(bflo(a.y) + bflo(b.y), bfhi(a.y) + bfhi(b.y));
  o.z = pk2(bflo(a.z) + bflo(b.z), bfhi(a.z) + bfhi(b.z));
  o.w = pk2(bflo(a.w) + bflo(b.w), bfhi(a.w) + bfhi(b.w));
  return o;
}
DI unsigned srt(float f) { unsigned u = __float_as_uint(f); return (u & 0x80000000u) ? ~u : (u | 0x80000000u); }
DI float unsrt(unsigned k) { unsigned u = (k & 0x80000000u) ? (k & 0x7fffffffu) : ~k; return __uint_as_float(u); }

DI void cvt_rows8(const float* __restrict__ src, u16* __restrict__ dst, size_t n8, size_t gtid, size_t nthr) {
  const float4* s = (const float4*)src;
  uint4* d = (uint4*)dst;
  for (size_t i = gtid; i < n8; i += nthr) {
    float4 a = s[2 * i], b = s[2 * i + 1];
    uint4 o;
    o.x = pk2(a.x, a.y); o.y = pk2(a.z, a.w); o.z = pk2(b.x, b.y); o.w = pk2(b.z, b.w);
    d[i] = o;
  }
}


typedef float f32x2 __attribute__((ext_vector_type(2)));
DI void cvt_rows_fp8(const float* __restrict__ src, unsigned char* __restrict__ dst, size_t n16, float scale, size_t gtid, size_t nthr) {
  const float4* s = (const float4*)src;
  uint4* d = (uint4*)dst;
  for (size_t i = gtid; i < n16; i += nthr) {
    float4 a = s[4 * i], b = s[4 * i + 1], c = s[4 * i + 2], e = s[4 * i + 3];
    uint4 o;
    int w;
    w = __builtin_amdgcn_cvt_pk_fp8_f32(a.x * scale, a.y * scale, 0, false); w = __builtin_amdgcn_cvt_pk_fp8_f32(a.z * scale, a.w * scale, w, true); o.x = (unsigned)w;
    w = __builtin_amdgcn_cvt_pk_fp8_f32(b.x * scale, b.y * scale, 0, false); w = __builtin_amdgcn_cvt_pk_fp8_f32(b.z * scale, b.w * scale, w, true); o.y = (unsigned)w;
    w = __builtin_amdgcn_cvt_pk_fp8_f32(c.x * scale, c.y * scale, 0, false); w = __builtin_amdgcn_cvt_pk_fp8_f32(c.z * scale, c.w * scale, w, true); o.z = (unsigned)w;
    w = __builtin_amdgcn_cvt_pk_fp8_f32(e.x * scale, e.y * scale, 0, false); w = __builtin_amdgcn_cvt_pk_fp8_f32(e.z * scale, e.w * scale, w, true); o.w = (unsigned)w;
    d[i] = o;
  }
}
DI uint2 fp8x4_to_bf16x4(unsigned w) {
  const f32x2 lo = __builtin_amdgcn_cvt_pk_f32_fp8((int)w, false), hi = __builtin_amdgcn_cvt_pk_f32_fp8((int)w, true);
  uint2 o;
  o.x = __builtin_amdgcn_perm(__float_as_uint(lo[1]), __float_as_uint(lo[0]), 0x07060302u);
  o.y = __builtin_amdgcn_perm(__float_as_uint(hi[1]), __float_as_uint(hi[0]), 0x07060302u);
  return o;
}
constexpr float U_SCALE = 64.f, V_SCALE = 16.f;

template <bool WITH_F>
DI void rmsnorm_rows_t(const Params& p, const float* __restrict__ src, const float* __restrict__ g, u16* __restrict__ dst) {
  const int lane = threadIdx.x & 63;
  const int gw = blockIdx.x * 4 + (threadIdx.x >> 6), nw = gridDim.x * 4;
  float4 gv[4];
#pragma unroll
  for (int i = 0; i < 4; ++i) gv[i] = ((const float4*)g)[lane + 64 * i];
  float wf[WITH_F ? 128 : 1];
  if (WITH_F) {
#pragma unroll
    for (int i = 0; i < 4; ++i)
#pragma unroll
      for (int e = 0; e < 4; ++e) {
        const float4* wp = (const float4*)(p.w_in + (size_t)(4 * (lane + 64 * i) + e) * 5640 + 3584);
        const float4 a = wp[0], b = wp[1];
        float* d = wf + (i * 4 + e) * 8;
        d[0] = a.x; d[1] = a.y; d[2] = a.z; d[3] = a.w; d[4] = b.x; d[5] = b.y; d[6] = b.z; d[7] = b.w;
      }
  }
  for (int row = gw; row < NTOK; row += nw) {
    const float4* s = (const float4*)(src + (size_t)row * 1024);
    float4 v[4];
    float ss = 0.f;
#pragma unroll
    for (int i = 0; i < 4; ++i) {
      v[i] = s[lane + 64 * i];
      ss += v[i].x * v[i].x + v[i].y * v[i].y + v[i].z * v[i].z + v[i].w * v[i].w;
    }
#pragma unroll
    for (int d = 32; d >= 1; d >>= 1) ss += __shfl_xor(ss, d);
    const float rs = rsqrtf(ss * (1.f / 1024.f) + EPS);
    uint2* o = (uint2*)(dst + (size_t)row * 1024);
    float fd[8];
    if (WITH_F) {
#pragma unroll
      for (int h = 0; h < 8; ++h) fd[h] = 0.f;
    }
#pragma unroll
    for (int i = 0; i < 4; ++i) {
      const float y0 = v[i].x * rs * gv[i].x, y1 = v[i].y * rs * gv[i].y, y2 = v[i].z * rs * gv[i].z, y3 = v[i].w * rs * gv[i].w;
      uint2 w;
      w.x = pk2(y0, y1);
      w.y = pk2(y2, y3);
      o[lane + 64 * i] = w;
      if (WITH_F) {
#pragma unroll
        for (int h = 0; h < 8; ++h)
          fd[h] += y0 * wf[(i * 4 + 0) * 8 + h] + y1 * wf[(i * 4 + 1) * 8 + h] + y2 * wf[(i * 4 + 2) * 8 + h] + y3 * wf[(i * 4 + 3) * 8 + h];
      }
    }
    if (WITH_F) {
#pragma unroll
      for (int h = 0; h < 8; ++h)
#pragma unroll
        for (int d = 32; d >= 1; d >>= 1) fd[h] += __shfl_xor(fd[h], d);
      float mine = fd[0];
#pragma unroll
      for (int h = 1; h < 8; ++h) mine = (lane == h) ? fd[h] : mine;
      if (lane < 8) {
        const int b = row >> 12, l = row & 4095;
        ((float*)(p.ws + OFF_LOGF))[(size_t)(b * 8 + lane) * 4096 + l] = log_sigmoid(mine + p.f_bias[lane]);
      }
    }
  }
}

DI int srccol(int mat, int n) {
  if (mat == 0) {
    if (n < 3584) return n;
    if (n < 5632) return n + 8;
    return -1;
  }
  if (mat == 1) {
    int c = n >> 6, wi = n & 63;
    return wi < 32 ? 32 * c + wi : 1024 + 32 * c + wi - 32;
  }
  return n;
}

DI void transpose_tile(const float* __restrict__ src, int Nsrc, int K, u16* __restrict__ dst, int k0, int n0, int mat, float* tl) {
  const int tid = threadIdx.x, c = tid & 63, r0 = tid >> 6;
  const int sc = srccol(mat, n0 + c);
#pragma unroll
  for (int i = 0; i < 16; ++i) {
    int rr = r0 + 4 * i;
    float v = sc >= 0 ? src[(size_t)(k0 + rr) * Nsrc + sc] : 0.f;
    tl[c * 65 + rr] = v;
  }
  __syncthreads();
  const int kk = (tid & 31) * 2, c0 = tid >> 5;
#pragma unroll
  for (int i = 0; i < 8; ++i) {
    int cc = c0 + 8 * i;
    unsigned o = pk2(tl[cc * 65 + kk], tl[cc * 65 + kk + 1]);
    *(unsigned*)(dst + (size_t)(n0 + cc) * K + k0 + kk) = o;
  }
  __syncthreads();
}

DI void phase_prep(const Params& p, char* lds) {
  const int tid = threadIdx.x;
  const size_t nthr = (size_t)gridDim.x * 256, gtid = (size_t)blockIdx.x * 256 + tid;
  if (gtid == 0) {
    int* ctr = (int*)(p.ws + OFF_CTR);
    for (int i = 0; i < 16; ++i) ctr[i] = 0;
  }
  if (gtid < 2048) {
    const int g = (int)gtid >> 6, pp = (int)gtid & 63;
    const float step = expf(p.log_step[g]);
    const float ar = p.a_re[g * 64 + pp], ai = p.a_im[g * 64 + pp];
    const float mag = expf(ar * step);
    const float lr = mag * cosf(ai * step), li = mag * sinf(ai * step);
    const float nr = lr - 1.f, ni = li, den = ar * ar + ai * ai;
    const float cr = (nr * ar + ni * ai) / den, ci = (ni * ar - nr * ai) / den;
    float* lam = (float*)(p.ws + OFF_LAM);
    lam[(g * 64 + pp) * 2] = lr;
    lam[(g * 64 + pp) * 2 + 1] = li;
    u16* bb = (u16*)(p.ws + OFF_BB);
    u16* cm = (u16*)(p.ws + OFF_CM);
    for (int h = 0; h < 16; ++h) {
      float bre = p.b_re[(g * 64 + pp) * 16 + h], bim = p.b_im[(g * 64 + pp) * 16 + h];
      bb[(g * 128 + pp) * 16 + h] = (u16)f2bf(cr * bre - ci * bim);
      bb[(g * 128 + 64 + pp) * 16 + h] = (u16)f2bf(cr * bim + ci * bre);
      cm[(g * 16 + h) * 128 + pp] = (u16)f2bf(p.c_re[(g * 16 + h) * 64 + pp]);
      cm[(g * 16 + h) * 128 + 64 + pp] = (u16)f2bf(-p.c_im[(g * 16 + h) * 64 + pp]);
    }
  }
  {
    float* tl = (float*)lds;
    for (int t = blockIdx.x; t < 2432; t += gridDim.x) {
      if (t < 1408) {
        int kt = t % 16, nt = t / 16;
        transpose_tile(p.w_in, 5640, 1024, (u16*)(p.ws + OFF_WIN), kt * 64, nt * 64, 0, tl);
      } else if (t < 1664) {
        int u = t - 1408, kt = u % 8, nt = u / 8;
        transpose_tile(p.w_glu, 2048, 512, (u16*)(p.ws + OFF_WGLU), kt * 64, nt * 64, 1, tl);
      } else if (t < 1920) {
        int u = t - 1664, kt = u % 16, nt = u / 16;
        transpose_tile(p.w_out, 1024, 1024, (u16*)(p.ws + OFF_WOUT), kt * 64, nt * 64, 2, tl);
      } else {
        int u = t - 1920, kt = u % 16, nt = u / 16;
        transpose_tile(p.w_query, 2048, 1024, (u16*)(p.ws + OFF_WQ), kt * 64, nt * 64, 3, tl);
      }
    }
  }
  rmsnorm_rows_t<true>(p, p.x, p.mix_g, (u16*)(p.ws + OFF_H));
  cvt_rows8(p.sub_keys, (u16*)(p.ws + OFF_SK), 8ull * 2 * 128 * 128 / 8, gtid, nthr);

}

enum { G_INPROJ = 0, G_GLU = 1, G_OUT = 2, G_PQ = 3 };

#define RAW_BARRIER() do { asm volatile("s_waitcnt lgkmcnt(0)" ::: "memory"); __builtin_amdgcn_s_barrier(); asm volatile("" ::: "memory"); } while (0)

template <int K, int MODE>
DI void gemm_tile(const Params& p, const u16* __restrict__ A, const u16* __restrict__ W, int mt, int nt, char* lds) {
  constexpr int WB = 256 * 64, AB = 128 * 64, SB = WB + AB;
  constexpr int NK = K / 32;
  const int tid = threadIdx.x, lane = tid & 63, w = tid >> 6, wn = w >> 1, wm = w & 1, r = lane & 31, hh = lane >> 5;
  const int lrow = tid >> 2, gc = (tid & 3) ^ ((tid >> 4) & 3);
  const u16* gW = W + (size_t)(nt * 256 + lrow) * K + gc * 8;
  const u16* gA = A + (size_t)(mt * 128 + lrow) * K + gc * 8;
  f32x16 acc[4][2];
#pragma unroll
  for (int a = 0; a < 4; ++a)
#pragma unroll
    for (int b = 0; b < 2; ++b)
#pragma unroll
      for (int i = 0; i < 16; ++i) acc[a][b][i] = 0.f;
  auto issue = [&](int kt, int st) {
    char* base = lds + st * SB + tid * 16;
#pragma unroll
    for (int i = 0; i < 4; ++i)
      __builtin_amdgcn_global_load_lds((const unsigned*)(gW + (size_t)(64 * i) * K + kt * 32),
                                       (__attribute__((address_space(3))) unsigned*)(base + i * 4096), 16, 0, 0);
#pragma unroll
    for (int i = 0; i < 2; ++i)
      __builtin_amdgcn_global_load_lds((const unsigned*)(gA + (size_t)(64 * i) * K + kt * 32),
                                       (__attribute__((address_space(3))) unsigned*)(base + WB + i * 4096), 16, 0, 0);
  };
  const int sw = (r >> 2) & 3;
  asm volatile("s_waitcnt vmcnt(0)" ::: "memory");
  RAW_BARRIER();
  issue(0, 0); issue(1, 1);
  int cs = 0, ls = 2;
  for (int kt = 0; kt < NK; ++kt) {
    if (kt + 1 < NK) asm volatile("s_waitcnt vmcnt(6)" ::: "memory");
    else asm volatile("s_waitcnt vmcnt(0)" ::: "memory");
    RAW_BARRIER();
    if (kt + 2 < NK) issue(kt + 2, ls);
    const char* lw = lds + cs * SB + (wn * 128 + r) * 64;
    const char* la = lds + cs * SB + WB + (wm * 64 + r) * 64;
#pragma unroll
    for (int s = 0; s < 2; ++s) {
      bf16x8 fw[4], fa[2];
      const int po = ((2 * s + hh) ^ sw) * 16;
#pragma unroll
      for (int j = 0; j < 4; ++j) fw[j] = *(const bf16x8*)(lw + j * 32 * 64 + po);
#pragma unroll
      for (int j = 0; j < 2; ++j) fa[j] = *(const bf16x8*)(la + j * 32 * 64 + po);
#pragma unroll
      for (int nb = 0; nb < 4; ++nb)
#pragma unroll
        for (int mb = 0; mb < 2; ++mb) acc[nb][mb] = mfma32(fw[nb], fa[mb], acc[nb][mb]);
    }
    cs = cs == 2 ? 0 : cs + 1;
    ls = ls == 2 ? 0 : ls + 1;
  }
  const int mbase = mt * 128 + wm * 64 + r;
  const int nc = 2 * nt + wn;
  if (MODE == G_INPROJ) {
    const bool isq = (nc >= 4 && nc < 12);
#pragma unroll
    for (int nb = 0; nb < 4; ++nb)
#pragma unroll
      for (int mb = 0; mb < 2; ++mb)
#pragma unroll
        for (int ig = 0; ig < 4; ++ig) {
          const int nl = nb * 32 + ig * 8 + hh * 4;
          const int m = mbase + mb * 32;
          float v0 = acc[nb][mb][4 * ig], v1 = acc[nb][mb][4 * ig + 1], v2 = acc[nb][mb][4 * ig + 2], v3 = acc[nb][mb][4 * ig + 3];
          if (nc < 4) {
            uint2 o; o.x = pk2(v0, v1); o.y = pk2(v2, v3);
            *(uint2*)((u16*)(p.ws + OFF_U) + (size_t)m * 512 + nc * 128 + nl) = o;
          } else if (nc < 20) {
            uint2 o; o.x = pk2(v0, v1); o.y = pk2(v2, v3);
            size_t off = isq ? OFF_Q : OFF_K;
            int hd = isq ? nc - 4 : nc - 12;
            *(uint2*)((u16*)(p.ws + off) + (size_t)m * 1024 + hd * 128 + nl) = o;
          } else if (nc < 28) {
            uint2 o; o.x = pk2(v0, v1); o.y = pk2(v2, v3);
            *(uint2*)((u16*)(p.ws + OFF_V) + (size_t)m * 1024 + (nc - 20) * 128 + nl) = o;
          } else if (nc < 44) {
            uint2 o; o.x = pk2(sigmoidf_(v0), sigmoidf_(v1)); o.y = pk2(sigmoidf_(v2), sigmoidf_(v3));
            size_t off = nc < 36 ? OFF_GS : OFF_GA;
            int cb = nc < 36 ? nc - 28 : nc - 36;
            *(uint2*)((u16*)(p.ws + off) + (size_t)m * 1024 + cb * 128 + nl) = o;
          } else if (nc == 44) {
            if (nb == 0 && ig == 0) {
              const int b = m >> 12, l = m & 4095;
              float* lf = (float*)(p.ws + OFF_LOGF);
              const int h0 = hh * 4;
              lf[(size_t)(b * 8 + h0 + 0) * 4096 + l] = log_sigmoid(v0 + p.f_bias[h0 + 0]);
              lf[(size_t)(b * 8 + h0 + 1) * 4096 + l] = log_sigmoid(v1 + p.f_bias[h0 + 1]);
              lf[(size_t)(b * 8 + h0 + 2) * 4096 + l] = log_sigmoid(v2 + p.f_bias[h0 + 2]);
              lf[(size_t)(b * 8 + h0 + 3) * 4096 + l] = log_sigmoid(v3 + p.f_bias[h0 + 3]);
            }
          }
        }
  } else if (MODE == G_GLU) {
#pragma unroll
    for (int j = 0; j < 2; ++j)
#pragma unroll
      for (int mb = 0; mb < 2; ++mb)
#pragma unroll
        for (int ig = 0; ig < 4; ++ig) {
          const int c = 2 * nc + j;
          const int n = 32 * c + ig * 8 + hh * 4;
          const int m = mbase + mb * 32;
          uint2 gs = *(const uint2*)((const u16*)(p.ws + OFF_GS) + (size_t)m * 1024 + n);
          uint2 ma = *(const uint2*)((const u16*)(p.ws + OFF_Q) + (size_t)m * 1024 + n);
          float y0 = acc[2 * j][mb][4 * ig] * sigmoidf_(acc[2 * j + 1][mb][4 * ig]) * bflo(gs.x) + bflo(ma.x);
          float y1 = acc[2 * j][mb][4 * ig + 1] * sigmoidf_(acc[2 * j + 1][mb][4 * ig + 1]) * bfhi(gs.x) + bfhi(ma.x);
          float y2 = acc[2 * j][mb][4 * ig + 2] * sigmoidf_(acc[2 * j + 1][mb][4 * ig + 2]) * bflo(gs.y) + bflo(ma.y);
          float y3 = acc[2 * j][mb][4 * ig + 3] * sigmoidf_(acc[2 * j + 1][mb][4 * ig + 3]) * bfhi(gs.y) + bfhi(ma.y);
          uint2 o; o.x = pk2(y0, y1); o.y = pk2(y2, y3);
          *(uint2*)((u16*)(p.ws + OFF_H) + (size_t)m * 1024 + n) = o;
        }
  } else {
#pragma unroll
    for (int nb = 0; nb < 4; ++nb)
#pragma unroll
      for (int mb = 0; mb < 2; ++mb)
#pragma unroll
        for (int ig = 0; ig < 4; ++ig) {
          const int n = nc * 128 + nb * 32 + ig * 8 + hh * 4;
          const int m = mbase + mb * 32;
          float v0 = acc[nb][mb][4 * ig], v1 = acc[nb][mb][4 * ig + 1], v2 = acc[nb][mb][4 * ig + 2], v3 = acc[nb][mb][4 * ig + 3];
          if (MODE == G_OUT) {
            float4 xv = *(const float4*)(p.x + (size_t)m * 1024 + n);
            xv.x += v0; xv.y += v1; xv.z += v2; xv.w += v3;
            *(float4*)(p.out + (size_t)m * 1024 + n) = xv;
          } else {
            uint2 o; o.x = pk2(v0, v1); o.y = pk2(v2, v3);
            *(uint2*)((u16*)(p.ws + OFF_V) + (size_t)m * 2048 + n) = o;
          }
        }
  }
}

DI void qknorm_rows(const Params& p) {
  const int lane = threadIdx.x & 63;
  const int gw = blockIdx.x * 4 + (threadIdx.x >> 6), nw = gridDim.x * 4;
  const int d0 = (lane & 7) * 16;
  for (int it = gw; it < 2 * NTOK; it += nw) {
    const int isk = it >= NTOK;
    const int row = isk ? it - NTOK : it;
    u16* base = (u16*)(p.ws + (isk ? OFF_K : OFF_Q)) + (size_t)row * 1024 + lane * 16;
    const float* g = (isk ? p.k_g : p.q_g) + d0;
    uint4 a = ld16(base), b = ld16(base + 8);
    float v[16];
    v[0] = bflo(a.x); v[1] = bfhi(a.x); v[2] = bflo(a.y); v[3] = bfhi(a.y); v[4] = bflo(a.z); v[5] = bfhi(a.z); v[6] = bflo(a.w); v[7] = bfhi(a.w);
    v[8] = bflo(b.x); v[9] = bfhi(b.x); v[10] = bflo(b.y); v[11] = bfhi(b.y); v[12] = bflo(b.z); v[13] = bfhi(b.z); v[14] = bflo(b.w); v[15] = bfhi(b.w);
    float ss = 0.f;
#pragma unroll
    for (int i = 0; i < 16; ++i) ss += v[i] * v[i];
    ss += __shfl_xor(ss, 1); ss += __shfl_xor(ss, 2); ss += __shfl_xor(ss, 4);
    const float rs = rsqrtf(ss * (1.f / 128.f) + EPS) * (isk ? 1.f : 0.08838834764831845f * 1.4426950408889634f);
#pragma unroll
    for (int i = 0; i < 16; ++i) v[i] *= rs * g[i];
    uint4 oa, ob;
    oa.x = pk2(v[0], v[1]); oa.y = pk2(v[2], v[3]); oa.z = pk2(v[4], v[5]); oa.w = pk2(v[6], v[7]);
    ob.x = pk2(v[8], v[9]); ob.y = pk2(v[10], v[11]); ob.z = pk2(v[12], v[13]); ob.w = pk2(v[14], v[15]);
    *(uint4*)base = oa; *(uint4*)(base + 8) = ob;
  }
}

template <int MODE>
DI void s5_item(const Params& p, int bg, int seg, char* ldsw) {
  const int lane = threadIdx.x & 63, r = lane & 31, hh = lane >> 5, c15 = lane & 15, quad = lane >> 4;
  const int b = bg >> 5, g = bg & 31;
  float* X = (float*)ldsw;
  const u16* bbp = (const u16*)(p.ws + OFF_BB);
  const u16* cmp = (const u16*)(p.ws + OFF_CM);
  bf16x8 Bf[4], Cf[4];
#pragma unroll
  for (int nb = 0; nb < 4; ++nb) Bf[nb] = as_bf(ld16(bbp + (g * 128 + nb * 32 + r) * 16 + hh * 8));
#pragma unroll
  for (int ks = 0; ks < 4; ++ks) Cf[ks] = as_bf(ld16(cmp + (g * 16 + c15) * 128 + ks * 32 + quad * 8));
  const float* lam = (const float*)(p.ws + OFF_LAM);
  const float lr = lam[(g * 64 + lane) * 2], li = lam[(g * 64 + lane) * 2 + 1];
  const float dsk = p.ssm_d[g * 16 + c15];
  u16* ub = (u16*)(p.ws + OFF_U) + (size_t)b * 4096 * 512 + g * 16;
  float sr = 0.f, si = 0.f;
  float2* Eg = (float2*)(p.ws + OFF_E) + (size_t)bg * 256;
  if (MODE == 1 && seg > 0) {
    float pr = lr, pi = li;
#pragma unroll
    for (int i = 0; i < 10; ++i) { const float nr = pr * pr - pi * pi, ni = 2.f * pr * pi; pr = nr; pi = ni; }
    for (int k = 0; k < seg; ++k) {
      const float2 e = Eg[k * 64 + lane];
      const float nr = pr * sr - pi * si + e.x, ni = pr * si + pi * sr + e.y;
      sr = nr; si = ni;
    }
  }
  const int cbeg = seg * 32;
  u16* Ul = (u16*)(ldsw + 16896);
  uint4 a_next = ld16(ub + (size_t)(cbeg * 32 + r) * 512 + hh * 8);
#pragma unroll 1
  for (int c = cbeg; c < cbeg + 32; ++c) {
    const int t0 = c * 32;
    const bf16x8 a = as_bf(a_next);
    if (MODE == 1) *(uint4*)(Ul + r * 16 + hh * 8) = a_next;
    if (c + 1 < cbeg + 32) a_next = ld16(ub + (size_t)((c + 1) * 32 + r) * 512 + hh * 8);
#pragma unroll
    for (int nb = 0; nb < 4; ++nb) {
      f32x16 z;
#pragma unroll
      for (int i = 0; i < 16; ++i) z[i] = 0.f;
      z = mfma32(a, Bf[nb], z);
#pragma unroll
      for (int i = 0; i < 16; ++i) X[crow(i, hh) * 132 + nb * 32 + r] = z[i];
    }
    __builtin_amdgcn_fence(__ATOMIC_RELEASE, "wavefront");
    __builtin_amdgcn_wave_barrier();
    __builtin_amdgcn_fence(__ATOMIC_ACQUIRE, "wavefront");
    float xr[32], xi[32];
#pragma unroll
    for (int t = 0; t < 32; ++t) { xr[t] = X[t * 132 + lane]; xi[t] = X[t * 132 + 64 + lane]; }
#pragma unroll
    for (int t = 0; t < 32; ++t) {
      float nsr = lr * sr - li * si + xr[t];
      float nsi = lr * si + li * sr + xi[t];
      sr = nsr; si = nsi;
      xr[t] = sr; xi[t] = si;
    }
    if (MODE == 1) {
#pragma unroll
    for (int t = 0; t < 32; ++t) { X[t * 132 + lane] = xr[t]; X[t * 132 + 64 + lane] = xi[t]; }
    __builtin_amdgcn_fence(__ATOMIC_RELEASE, "wavefront");
    __builtin_amdgcn_wave_barrier();
    __builtin_amdgcn_fence(__ATOMIC_ACQUIRE, "wavefront");
#pragma unroll
    for (int mb = 0; mb < 2; ++mb) {
      f32x4 y = {0.f, 0.f, 0.f, 0.f};
#pragma unroll
      for (int ks = 0; ks < 4; ++ks) {
        const float4 s0 = *(const float4*)(X + (16 * mb + c15) * 132 + ks * 32 + quad * 8);
        const float4 s1 = *(const float4*)(X + (16 * mb + c15) * 132 + ks * 32 + quad * 8 + 4);
        uint4 pk; pk.x = pk2(s0.x, s0.y); pk.y = pk2(s0.z, s0.w); pk.z = pk2(s1.x, s1.y); pk.w = pk2(s1.z, s1.w);
        y = mfma16(as_bf(pk), Cf[ks], y);
      }
#pragma unroll
      for (int j = 0; j < 4; ++j) {
        const int t = t0 + 16 * mb + 4 * quad + j;
        float yy = y[j] + dsk * bf2f(Ul[(16 * mb + 4 * quad + j) * 16 + c15]);
        ub[(size_t)t * 512 + c15] = (u16)f2bf(gelu_tanh(yy));
      }
    }
    }
    __builtin_amdgcn_fence(__ATOMIC_RELEASE, "wavefront");
    __builtin_amdgcn_wave_barrier();
    __builtin_amdgcn_fence(__ATOMIC_ACQUIRE, "wavefront");
  }
  if (MODE == 0) Eg[seg * 64 + lane] = make_float2(sr, si);
}


DI void cumsum_item(const Params& p, int bh) {
  const int lane = threadIdx.x & 63;
  const float4* lf = (const float4*)((const float*)(p.ws + OFF_LOGF) + (size_t)bh * 4096 + lane * 64);
  float4* co = (float4*)((float*)(p.ws + OFF_CUM) + (size_t)bh * 4096 + lane * 64);
  float run = 0.f;
  float4 v[16];
#pragma unroll
  for (int i = 0; i < 16; ++i) {
    float4 t = lf[i];
    t.x *= 1.4426950408889634f; t.y *= 1.4426950408889634f; t.z *= 1.4426950408889634f; t.w *= 1.4426950408889634f;
    t.x += run; t.y += t.x; t.z += t.y; t.w += t.z; run = t.w;
    v[i] = t;
  }
  float inc = run;
#pragma unroll
  for (int d = 1; d < 64; d <<= 1) { float t = __shfl_up(inc, d); if (lane >= d) inc += t; }
  const float off = inc - run;
#pragma unroll
  for (int i = 0; i < 16; ++i) { float4 t = v[i]; t.x += off; t.y += off; t.z += off; t.w += off; co[i] = t; }
}


DI void dma16(const void* g, unsigned lds_off) {
  asm volatile("s_mov_b32 m0, %0\n\ts_nop 0\n\tglobal_load_lds_dwordx4 %1, off" :: "s"(__builtin_amdgcn_readfirstlane(lds_off)), "v"(g) : "memory", "m0");
}
DI void dma4(const void* g, unsigned lds_off) {
  asm volatile("s_mov_b32 m0, %0\n\ts_nop 0\n\tglobal_load_lds_dword %1, off" :: "s"(__builtin_amdgcn_readfirstlane(lds_off)), "v"(g) : "memory", "m0");
}

DI void attn_item(const Params& p, int bh, int qb, char* lds) {
  constexpr int OPB = 32 * 256, SB = 2 * OPB;
  const int tid = threadIdx.x, lane = tid & 63, w = tid >> 6, r = lane & 31, hh = lane >> 5;
  float* cumS = (float*)(lds + 4 * SB) + w * 64;
  const int b = bh >> 3, h = bh & 7;
  const size_t tokbase = (size_t)b * 4096;
  const float* cumg = (const float*)(p.ws + OFF_CUM) + (size_t)bh * 4096;
  const int q0 = qb * 128;
  const int myq = q0 + 32 * w + r;
  const u16* Qg = (const u16*)(p.ws + OFF_Q) + (tokbase + myq) * 1024 + h * 128 + hh * 8;
  bf16x8 Qf[8];
#pragma unroll
  for (int s = 0; s < 8; ++s) Qf[s] = as_bf(ld16(Qg + s * 16));
  const float cq = cumg[myq];
  const int nkt = 4 * qb + 4;
  int kt0;
  {
    float gq = fmaxf(fabsf(p.q_g[lane]), fabsf(p.q_g[lane + 64])), gk = fmaxf(fabsf(p.k_g[lane]), fabsf(p.k_g[lane + 64]));
#pragma unroll
    for (int d = 32; d >= 1; d >>= 1) { gq = fmaxf(gq, __shfl_xor(gq, d)); gk = fmaxf(gk, __shfl_xor(gk, d)); }
    const float thr = -(40.f + 2.f * 1.01f * 11.313708499f * 1.4426950408889634f * gq * gk);
    const float c0 = cumg[q0];
    int* kmin = (int*)(lds + LDS_BYTES - 48);
    __syncthreads();
    if (tid == 0) *kmin = 4 * qb;
    __syncthreads();
    for (int t = tid; t < 4 * qb; t += 256)
      if (c0 - cumg[32 * t + 31] >= thr) atomicMin(kmin, t);
    __syncthreads();
    kt0 = *kmin;
  }
  const int lrow = tid >> 4;
  const int gcK = (tid & 15) ^ ((tid >> 4) & 15);
  const int gcV = (tid & 15) ^ (((tid >> 4) & 3) << 1);
  const u16* Kg = (const u16*)(p.ws + OFF_K) + (tokbase + lrow) * 1024 + h * 128 + gcK * 8;
  const u16* Vg = (const u16*)(p.ws + OFF_V) + (tokbase + lrow) * 1024 + h * 128 + gcV * 8;
  const unsigned lds0 = (unsigned)(size_t)lds;
  auto issue = [&](int kt) {
    const unsigned base = lds0 + (kt & 3) * SB + w * 1024;
#pragma unroll
    for (int i = 0; i < 2; ++i) {
      dma16(Kg + (size_t)(kt * 32 + 16 * i) * 1024, base + i * 4096);
      dma16(Vg + (size_t)(kt * 32 + 16 * i) * 1024, base + OPB + i * 4096);
    }
    dma4(cumg + kt * 32 + lane, lds0 + 4 * SB + (w * 64 + (kt & 3) * 256) * 4);
  };
  f32x16 oacc[4];
#pragma unroll
  for (int d = 0; d < 4; ++d)
#pragma unroll
    for (int i = 0; i < 16; ++i) oacc[d][i] = 0.f;
  float mrun = -INFINITY, lsum = 0.f;
  const int i16 = lane & 15, q4 = i16 >> 2, p4 = i16 & 3, blk = (lane >> 4) & 1;
  const int ksw = r & 15;
  asm volatile("s_waitcnt vmcnt(0)" ::: "memory");
  RAW_BARRIER();
  issue(kt0); issue(kt0 + 1); issue(kt0 + 2);
  auto compute = [&](int kt) {
    const char* Kl = lds + (kt & 3) * SB;
    const char* Vl = Kl + OPB;
    const float* cS = cumS + (kt & 3) * 256;
    f32x16 sacc;
#pragma unroll
    for (int ig = 0; ig < 4; ++ig) {
      const float4 ck = *(const float4*)(cS + 8 * ig + 4 * hh);
      sacc[4 * ig] = cq - ck.x; sacc[4 * ig + 1] = cq - ck.y; sacc[4 * ig + 2] = cq - ck.z; sacc[4 * ig + 3] = cq - ck.w;
    }
#pragma unroll
    for (int s = 0; s < 8; ++s) {
      bf16x8 kf = *(const bf16x8*)(Kl + r * 256 + (((2 * s + hh) ^ ksw) * 16));
      sacc = mfma32(kf, Qf[s], sacc);
    }
    if (kt >= 4 * qb) {
#pragma unroll
      for (int i = 0; i < 16; ++i) {
        const int key = kt * 32 + crow(i, hh);
        if (key > myq) sacc[i] = -INFINITY;
      }
    }
    float mx = sacc[0];
#pragma unroll
    for (int i = 1; i < 16; ++i) mx = fmaxf(mx, sacc[i]);
    mx = fmaxf(mx, __shfl_xor(mx, 32));
    if (__builtin_amdgcn_ballot_w64(mx > mrun + 20.f) != 0ull) {
      const float mnew = fmaxf(mrun, mx);
      const float alpha = __builtin_amdgcn_exp2f(mrun - mnew);
      mrun = mnew;
      lsum *= alpha;
#pragma unroll
      for (int d = 0; d < 4; ++d)
#pragma unroll
        for (int i = 0; i < 16; ++i) oacc[d][i] *= alpha;
    }
    float ps = 0.f;
#pragma unroll
    for (int i = 0; i < 16; ++i) {
      float e = __builtin_amdgcn_exp2f(sacc[i] - mrun);
      sacc[i] = e;
      ps += e;
    }
    lsum += ps;
#pragma unroll
    for (int sp = 0; sp < 2; ++sp) {
      uint4 pk;
      pk.x = pk2(sacc[8 * sp], sacc[8 * sp + 1]);
      pk.y = pk2(sacc[8 * sp + 2], sacc[8 * sp + 3]);
      pk.z = pk2(sacc[8 * sp + 4], sacc[8 * sp + 5]);
      pk.w = pk2(sacc[8 * sp + 6], sacc[8 * sp + 7]);
      const bf16x8 pf = as_bf(pk);
      const char* vrow = Vl + (16 * sp + 4 * hh + q4) * 256 + (p4 & 1) * 8;
#pragma unroll
      for (int db = 0; db < 4; ++db) {
        const int po = ((4 * db + 2 * blk + (p4 >> 1)) ^ (q4 << 1)) * 16;
        s16x4 lo = __builtin_amdgcn_ds_read_tr16_b64_v4i16((__attribute__((address_space(3))) s16x4*)(vrow + po));
        s16x4 hi = __builtin_amdgcn_ds_read_tr16_b64_v4i16((__attribute__((address_space(3))) s16x4*)(vrow + 8 * 256 + po));
        bf16x8 vf = __builtin_shufflevector(lo, hi, 0, 1, 2, 3, 4, 5, 6, 7);
        oacc[db] = mfma32(vf, pf, oacc[db]);
      }
    }
  };
  for (int kt = kt0; kt < nkt; ++kt) {
    if (kt + 2 < nkt) asm volatile("s_waitcnt vmcnt(10)" ::: "memory");
    else if (kt + 1 < nkt) asm volatile("s_waitcnt vmcnt(5)" ::: "memory");
    else asm volatile("s_waitcnt vmcnt(0)" ::: "memory");
    RAW_BARRIER();
    if (kt + 3 < nkt) issue(kt + 3);
    compute(kt);
  }
  const float ltot = lsum + __shfl_xor(lsum, 32);
  const float inv = 1.f / ltot;
  const u16* gag = (const u16*)(p.ws + OFF_GA) + (tokbase + myq) * 1024 + h * 128;
  u16* og = (u16*)(p.ws + OFF_Q) + (tokbase + myq) * 1024 + h * 128;
#pragma unroll
  for (int db = 0; db < 4; ++db)
#pragma unroll
    for (int ig = 0; ig < 4; ++ig) {
      const int d = 32 * db + 8 * ig + 4 * hh;
      uint2 ga = *(const uint2*)(gag + d);
      uint2 o;
      o.x = pk2(oacc[db][4 * ig] * inv * bflo(ga.x), oacc[db][4 * ig + 1] * inv * bfhi(ga.x));
      o.y = pk2(oacc[db][4 * ig + 2] * inv * bflo(ga.y), oacc[db][4 * ig + 3] * inv * bfhi(ga.y));
      *(uint2*)(og + d) = o;
    }
}

DI void ins32(unsigned (&L)[16], unsigned k) {
#pragma unroll
  for (int j = 0; j < 16; ++j) {
    unsigned hi = L[j] > k ? L[j] : k;
    k = L[j] > k ? k : L[j];
    L[j] = hi;
  }
}
DI void ins64(u64 (&M)[16], u64 k) {
#pragma unroll
  for (int j = 0; j < 16; ++j) {
    const bool gt = k > M[j];
    const u64 hi = gt ? k : M[j];
    const u64 lo = gt ? M[j] : k;
    M[j] = hi;
    k = lo;
  }
}


DI void cex_desc(unsigned& a, unsigned& b) { const unsigned hi = a > b ? a : b, lo = a > b ? b : a; a = hi; b = lo; }
DI void bitonic_sort16_desc(unsigned (&v)[16]) {
#pragma unroll
  for (int k = 2; k <= 16; k <<= 1)
#pragma unroll
    for (int j = k >> 1; j >= 1; j >>= 1)
#pragma unroll
      for (int i = 0; i < 16; ++i) {
        const int l = i ^ j;
        if (l > i) {
          if ((i & k) == 0) cex_desc(v[i], v[l]);
          else cex_desc(v[l], v[i]);
        }
      }
}
DI void merge_top16_desc(unsigned (&a)[16], const unsigned (&b)[16]) {
#pragma unroll
  for (int i = 0; i < 16; ++i) a[i] = a[i] > b[15 - i] ? a[i] : b[15 - i];
#pragma unroll
  for (int j = 8; j >= 1; j >>= 1)
#pragma unroll
    for (int i = 0; i < 16; ++i) {
      const int l = i ^ j;
      if (l > i) cex_desc(a[i], a[l]);
    }
}

DI void route_item(const Params& p, int tt, int h, const char* skl) {
  const int lane = threadIdx.x & 63, r = lane & 31, hh = lane >> 5;
  const int tok = tt * 32 + r;
  const u16* pq = (const u16*)(p.ws + OFF_V) + (size_t)tok * 2048 + h * 256 + hh * 8;
  uint4 bqv[16];
#pragma unroll
  for (int i = 0; i < 16; ++i) bqv[i] = ld16(pq + (i >> 3) * 128 + (i & 7) * 16);
  const char* skr = skl + r * 256;
  const int ksw = r & 15;
  unsigned L[2][16];
  const unsigned hsel = (unsigned)hh << 2;
#pragma unroll
  for (int c = 0; c < 2; ++c) {
    f32x16 acc[4];
#pragma unroll
    for (int kb = 0; kb < 4; ++kb)
#pragma unroll
      for (int i = 0; i < 16; ++i) acc[kb][i] = 0.f;
#pragma unroll
    for (int s = 0; s < 8; ++s) {
      const bf16x8 bq = as_bf(bqv[c * 8 + s]);
#pragma unroll
      for (int kb = 0; kb < 4; ++kb) {
        const bf16x8 ak = *(const bf16x8*)(skr + (c * 128 + kb * 32) * 256 + (((2 * s + hh) ^ ksw) * 16));
        acc[kb] = mfma32(ak, bq, acc[kb]);
      }
      __builtin_amdgcn_sched_barrier(0);
    }
#pragma unroll
    for (int kb = 0; kb < 4; ++kb) {
      unsigned G[16];
#pragma unroll
      for (int i = 0; i < 16; ++i) G[i] = (srt(acc[kb][i]) & ~127u) | (unsigned)(127 - (32 * kb + crow(i, 0)));
      bitonic_sort16_desc(G);
      if (kb == 0) {
#pragma unroll
        for (int i = 0; i < 16; ++i) L[c][i] = G[i];
      } else {
        merge_top16_desc(L[c], G);
      }
      __builtin_amdgcn_sched_barrier(0);
    }
    unsigned P[16];
#pragma unroll
    for (int j = 0; j < 16; ++j) { L[c][j] ^= hsel; P[j] = (unsigned)__shfl_xor((int)L[c][j], 32); }
    merge_top16_desc(L[c], P);
  }
  float s0[16], s1[16];
  unsigned W0[4] = {0u, 0u, 0u, 0u}, W1[4] = {0u, 0u, 0u, 0u};
#pragma unroll
  for (int j = 0; j < 16; ++j) {
    s0[j] = unsrt(L[0][j] & ~127u);
    s1[j] = unsrt(L[1][j] & ~127u);
    W0[j >> 2] |= (127u - (L[0][j] & 127u)) << (8 * (j & 3));
    W1[j >> 2] |= (127u - (L[1][j] & 127u)) << (8 * (j & 3));
  }
  unsigned M[16];
  {
    unsigned C[64];
    int n = 0;
#pragma unroll
    for (int i = 0; i < 16; ++i)
#pragma unroll
      for (int j = 0; j < 16; ++j)
        if ((i + 1) * (j + 1) <= 16) {
          const float s = s0[i] + s1[j];
          C[n++] = (srt(s) & ~255u) | (unsigned)(255 - (i * 16 + j));
        }
#pragma unroll
    for (int k = 50; k < 64; ++k) C[k] = 0u;
#pragma unroll
    for (int gi = 0; gi < 4; ++gi) {
      unsigned G[16];
#pragma unroll
      for (int i = 0; i < 16; ++i) G[i] = C[gi * 16 + i];
      bitonic_sort16_desc(G);
      if (gi == 0) {
#pragma unroll
        for (int i = 0; i < 16; ++i) M[i] = G[i];
      } else {
        merge_top16_desc(M, G);
      }
      __builtin_amdgcn_sched_barrier(0);
    }
  }
  float bs[16], den = 0.f;
  unsigned eidx[16];
  const float top = unsrt(M[0] & ~255u);
#pragma unroll
  for (int j = 0; j < 16; ++j) {
    bs[j] = __expf(unsrt(M[j] & ~255u) - top);
    den += bs[j];
    const unsigned code = 255u - (M[j] & 255u);
    const unsigned ci = code >> 4, cj = code & 15u;
    const unsigned wi = ci < 8 ? (ci < 4 ? W0[0] : W0[1]) : (ci < 12 ? W0[2] : W0[3]);
    const unsigned wj = cj < 8 ? (cj < 4 ? W1[0] : W1[1]) : (cj < 12 ? W1[2] : W1[3]);
    eidx[j] = ((wi >> (8 * (ci & 3))) & 127u) * 128u + ((wj >> (8 * (cj & 3))) & 127u);
  }
  const float inv = 1.f / den;
  if (hh == 0) {
    uint4* rt = (uint4*)(p.ws + OFF_GA) + ((size_t)tok * 8 + h) * 8;
#pragma unroll
    for (int j = 0; j < 8; ++j) {
      uint4 o;
      o.x = eidx[2 * j]; o.y = __float_as_uint(bs[2 * j] * inv);
      o.z = eidx[2 * j + 1]; o.w = __float_as_uint(bs[2 * j + 1] * inv);
      rt[j] = o;
    }
  }
}

template <int VAR>
DI void expert_token(const Params& p, int tok, char* ldsw) {
  const int lane = threadIdx.x & 63, c15 = lane & 15, quad = lane >> 4;
  const unsigned char* Ub = (const unsigned char*)(p.ws + OFF_UBF);
  const unsigned char* Vb = (const unsigned char*)(p.ws + OFF_VBF);
  const uint2* rt = (const uint2*)(p.ws + OFF_GA) + (size_t)tok * 128;
  const u16* h2 = (const u16*)(p.ws + OFF_K) + (size_t)tok * 1024;
  uint2 re = rt[c15];
  const uint4 h2a = ld16(h2 + lane * 16), h2b = ld16(h2 + lane * 16 + 8);
  float o[16];
#pragma unroll
  for (int i = 0; i < 16; ++i) o[i] = 0.f;
  uint4 ub[16];
  if (VAR != 2) {
    const unsigned char* urow = Ub + (size_t)re.x * 1024 + quad * 16;
#pragma unroll
    for (int kd = 0; kd < 16; ++kd) ub[kd] = ld16(urow + kd * 64);
  }
  __builtin_amdgcn_sched_barrier(0);
  *(uint4*)(ldsw + lane * 32) = h2a;
  *(uint4*)(ldsw + lane * 32 + 16) = h2b;
  __builtin_amdgcn_fence(__ATOMIC_RELEASE, "wavefront");
  __builtin_amdgcn_wave_barrier();
  __builtin_amdgcn_fence(__ATOMIC_ACQUIRE, "wavefront");
#pragma unroll 1
  for (int hd = 0; hd < 8; ++hd) {
    const int e = (int)re.x;
    const float g = __uint_as_float(re.y);
    const uint2 ren = rt[((hd + 1) & 7) * 16 + c15];
    uint4 vb[16];
    if (VAR != 1) {
#pragma unroll
      for (int j = 0; j < 16; ++j) vb[j] = ld16(Vb + (size_t)__builtin_amdgcn_readlane(e, j) * 1024 + lane * 16);
    }
    __builtin_amdgcn_sched_barrier(0);
    f32x4 acc = {0.f, 0.f, 0.f, 0.f};
    if (VAR != 2)
#pragma unroll
    for (int kd = 0; kd < 16; ++kd) {
      const uint4 bq = ub[kd];
      const bf16x8 a0 = *(const bf16x8*)(ldsw + (kd * 64 + quad * 16) * 2);
      const bf16x8 a1 = *(const bf16x8*)(ldsw + (kd * 64 + quad * 16) * 2 + 16);
      const uint2 b0l = fp8x4_to_bf16x4(bq.x), b0h = fp8x4_to_bf16x4(bq.y), b1l = fp8x4_to_bf16x4(bq.z), b1h = fp8x4_to_bf16x4(bq.w);
      uint4 b0, b1;
      b0.x = b0l.x; b0.y = b0l.y; b0.z = b0h.x; b0.w = b0h.y;
      b1.x = b1l.x; b1.y = b1l.y; b1.z = b1h.x; b1.w = b1h.y;
      acc = mfma16(a0, as_bf(b0), acc);
      acc = mfma16(a1, as_bf(b1), acc);
    }
    const float wgt = g * gelu_tanh(acc[0] * (1.f / U_SCALE)) * (1.f / V_SCALE);
    if (hd + 1 < 8) {
      re = ren;
      if (VAR != 2) {
        const unsigned char* urow = Ub + (size_t)re.x * 1024 + quad * 16;
#pragma unroll
        for (int kd = 0; kd < 16; ++kd) ub[kd] = ld16(urow + kd * 64);
      }
    }
    __builtin_amdgcn_sched_barrier(0);
    if (VAR == 1) { o[hd] += wgt; continue; }
#pragma unroll
    for (int j = 0; j < 16; ++j) {
      const float wj = __uint_as_float(__builtin_amdgcn_readlane(__float_as_uint(wgt), j));
      const uint4 v = vb[j];
      f32x2 t;
      t = __builtin_amdgcn_cvt_pk_f32_fp8((int)v.x, false); o[0] += wj * t[0]; o[1] += wj * t[1];
      t = __builtin_amdgcn_cvt_pk_f32_fp8((int)v.x, true);  o[2] += wj * t[0]; o[3] += wj * t[1];
      t = __builtin_amdgcn_cvt_pk_f32_fp8((int)v.y, false); o[4] += wj * t[0]; o[5] += wj * t[1];
      t = __builtin_amdgcn_cvt_pk_f32_fp8((int)v.y, true);  o[6] += wj * t[0]; o[7] += wj * t[1];
      t = __builtin_amdgcn_cvt_pk_f32_fp8((int)v.z, false); o[8] += wj * t[0]; o[9] += wj * t[1];
      t = __builtin_amdgcn_cvt_pk_f32_fp8((int)v.z, true);  o[10] += wj * t[0]; o[11] += wj * t[1];
      t = __builtin_amdgcn_cvt_pk_f32_fp8((int)v.w, false); o[12] += wj * t[0]; o[13] += wj * t[1];
      t = __builtin_amdgcn_cvt_pk_f32_fp8((int)v.w, true);  o[14] += wj * t[0]; o[15] += wj * t[1];
      __builtin_amdgcn_sched_barrier(0);
    }
  }
  if (VAR != 0) {
    float sacc_ = 0.f;
#pragma unroll
    for (int i = 0; i < 16; ++i) sacc_ += o[i];
    if (sacc_ == 12345.678f) ((float*)(p.ws + OFF_CUM))[lane] = sacc_;
    return;
  }
  float4* out = (float4*)(p.out + (size_t)tok * 1024 + lane * 16);
  float4 x0 = out[0], x1 = out[1], x2 = out[2], x3 = out[3];
  x0.x += o[0]; x0.y += o[1]; x0.z += o[2]; x0.w += o[3];
  x1.x += o[4]; x1.y += o[5]; x1.z += o[6]; x1.w += o[7];
  x2.x += o[8]; x2.y += o[9]; x2.z += o[10]; x2.w += o[11];
  x3.x += o[12]; x3.y += o[13]; x3.z += o[14]; x3.w += o[15];
  out[0] = x0; out[1] = x1; out[2] = x2; out[3] = x3;
  __builtin_amdgcn_fence(__ATOMIC_RELEASE, "wavefront");
  __builtin_amdgcn_wave_barrier();
  __builtin_amdgcn_fence(__ATOMIC_ACQUIRE, "wavefront");
}

template <class F>
DI void walk_tiles(int NT, int nw, F&& f) {
  const int x = blockIdx.x & 7, j = blockIdx.x >> 3, nloc = gridDim.x >> 3;
  const int mpc = 64 / nw;
  const int ngr = (NT + nw - 1) / nw, mgr = 32 / mpc;
  for (int c = 0; c < mgr * ngr; ++c) {
    const int mg = c / ngr, ng = c % ngr;
    for (int u = j; u < 64; u += nloc) {
      const int mt = 32 * x + mg * mpc + (u % mpc), nt = ng * nw + u / mpc;
      if (nt < NT) f(mt, nt);
    }
  }
}

#define XB_TMO      128
#define XB_XCNT(j)  (256  + 64 * (j))
#define XB_XSUB(j)  (1280 + 64 * (j))
#define XB_XGEN(j)  (2304 + 64 * (j))
#define XB_TOP      3328
#define XB_TOPGEN   3392
#define XCD_BAR_WORDS 3456
#define XB_SPIN_CAP (1u << 22)
#define LAS __attribute__((address_space(3)))
DI unsigned xb_ld(unsigned* p) { return __hip_atomic_load(p, __ATOMIC_RELAXED, __HIP_MEMORY_SCOPE_AGENT); }
DI unsigned xb_add(unsigned* p, unsigned v) { return __hip_atomic_fetch_add(p, v, __ATOMIC_RELAXED, __HIP_MEMORY_SCOPE_AGENT); }
DI unsigned xb_xcc_id() { return (unsigned)__builtin_amdgcn_s_getreg((3 << 11) | 20) & 0xFu; }
#define XB_SPIN(cond, bar) do { unsigned _sp = 0; while (cond) { __builtin_amdgcn_s_sleep(1); \
    if ((++_sp & 255u) == 0u) { if (xb_ld(&(bar)[XB_TMO])) break; if (_sp > XB_SPIN_CAP) { atomicAdd(&(bar)[XB_TMO], 1u); break; } } } } while (0)
struct XcdBarrier { unsigned* bar; unsigned x; volatile LAS unsigned* st; };
DI XcdBarrier xcd_barrier_post(unsigned* bar, volatile LAS unsigned* st) {
  XcdBarrier b; b.bar = bar; b.x = xb_xcc_id(); b.st = st;
  if (threadIdx.x == 0) (void)xb_add(&bar[XB_XCNT(b.x)], 1u);
  return b;
}
DI void xcd_barrier_complete(unsigned* bar, unsigned x, unsigned& nloc, unsigned& nx) {
  const unsigned G = gridDim.x * gridDim.y * gridDim.z;
  unsigned sum, cnt, mine, sp = 0u;
  for (;;) {
    sum = 0u; cnt = 0u; mine = 0u;
#pragma unroll
    for (unsigned j = 0; j < 16; ++j) { const unsigned c = xb_ld(&bar[XB_XCNT(j)]); sum += c; cnt += (c > 0u) ? 1u : 0u; mine = (j == x) ? c : mine; }
    if (sum == G) break;
    __builtin_amdgcn_s_sleep(1);
    if ((++sp & 255u) == 0u) { if (xb_ld(&bar[XB_TMO])) break; if (sp > XB_SPIN_CAP) { atomicAdd(&bar[XB_TMO], 1u); break; } }
  }
  nloc = mine > 0u ? mine : 1u; nx = cnt > 0u ? cnt : 1u;
}
DI void xcd_barrier(const XcdBarrier& b) {
  asm volatile("s_waitcnt vmcnt(0)" ::: "memory");
  __syncthreads();
  if (threadIdx.x == 0) {
    unsigned* bar = b.bar;
    __builtin_amdgcn_s_waitcnt(0);
    unsigned nloc = b.st[0], nx = b.st[1];
    if (nloc == 0u) { xcd_barrier_complete(bar, b.x, nloc, nx); b.st[0] = nloc; b.st[1] = nx; }
    const unsigned old = xb_add(&bar[XB_XSUB(b.x)], 1u);
    const unsigned gen = old / nloc;
    if (old + 1u == (gen + 1u) * nloc) {
      __builtin_amdgcn_fence(__ATOMIC_RELEASE, "agent");
      asm volatile("s_waitcnt vmcnt(0)" ::: "memory");
      const unsigned og = xb_add(&bar[XB_TOP], 1u);
      const unsigned tg = og / nx;
      if (og + 1u == (tg + 1u) * nx) xb_add(&bar[XB_TOPGEN], 1u);
      else XB_SPIN(xb_ld(&bar[XB_TOPGEN]) == tg, bar);
      __builtin_amdgcn_fence(__ATOMIC_ACQUIRE, "agent");
      xb_add(&bar[XB_XGEN(b.x)], 1u);
      asm volatile("s_waitcnt vmcnt(0)" ::: "memory");
    } else {
      XB_SPIN(xb_ld(&bar[XB_XGEN(b.x)]) == gen, bar);
      __builtin_amdgcn_fence(__ATOMIC_ACQUIRE, "agent");
      asm volatile("s_waitcnt vmcnt(0)" ::: "memory");
    }
  }
  __syncthreads();
}

template <int PH>
DI void run_phase(const Params& p, char* lds) {
  const int tid = threadIdx.x, w = tid >> 6;
  if (PH == 0) {
    phase_prep(p, lds);
  } else if (PH == 1) {
    {
      const int x = blockIdx.x & 7, j = blockIdx.x >> 3, nloc = gridDim.x >> 3;
      for (int c = 0; c < 11; ++c)
        for (int u = j; u < 64; u += nloc) {
          int mt, nt;
          if (c < 10) { mt = 32 * x + 16 * (c / 5) + (u & 15); nt = 4 * (c % 5) + (u >> 4); }
          else { mt = 32 * x + (u & 31); nt = 20 + (u >> 5); }
          gemm_tile<1024, G_INPROJ>(p, (const u16*)(p.ws + OFF_H), (const u16*)(p.ws + OFF_WIN), mt, nt, lds);
        }
    }
  } else if (PH == 2 || PH == 12 || PH == 13) {
    int* ctr = (int*)(p.ws + OFF_CTR) + (blockIdx.x & 7) + (PH == 2 ? 0 : 8);
    const int x = blockIdx.x & 7;
    int* s_item = (int*)(lds + LDS_BYTES - 16);
    for (;;) {
      __syncthreads();
      if (tid == 0) *s_item = atomicAdd(ctr, 1);
      __syncthreads();
      const int it = *s_item;
      if (it >= 32 + 256) break;
      if (it < 32) {
        if (PH != 13) s5_item<1>(p, x * 32 + it, w, lds + w * 17920);
      } else {
        const int a = it - 32;
        attn_item(p, x * 8 + (a & 7), 31 - (a >> 3), lds);
      }
    }
  } else if (PH == 3) {
    walk_tiles(8, 8, [&](int mt, int nt) {
      gemm_tile<512, G_GLU>(p, (const u16*)(p.ws + OFF_U), (const u16*)(p.ws + OFF_WGLU), mt, nt, lds);
    });
  } else if (PH == 4) {
    walk_tiles(4, 4, [&](int mt, int nt) {
      gemm_tile<1024, G_OUT>(p, (const u16*)(p.ws + OFF_H), (const u16*)(p.ws + OFF_WOUT), mt, nt, lds);
    });
  } else if (PH == 5) {
    rmsnorm_rows_t<false>(p, p.out, p.ffn_g, (u16*)(p.ws + OFF_K));
  } else if (PH == 6) {
    walk_tiles(8, 8, [&](int mt, int nt) {
      gemm_tile<1024, G_PQ>(p, (const u16*)(p.ws + OFF_K), (const u16*)(p.ws + OFF_WQ), mt, nt, lds);
    });
  } else if (PH == 7) {
    const int gw = blockIdx.x * 4 + w, nw = gridDim.x * 4;
    {
      const int h = blockIdx.x & 7, jb = blockIdx.x >> 3, nloc = gridDim.x >> 3;
      const u16* skg = (const u16*)(p.ws + OFF_SK) + (size_t)h * 256 * 128;
#pragma unroll 4
      for (int i = 0; i < 16; ++i) {
        const int ci = tid + 256 * i, row = ci >> 4, pc = ci & 15, gc = pc ^ (row & 15);
        *(uint4*)(lds + row * 256 + pc * 16) = ld16(skg + row * 128 + gc * 8);
      }
      __syncthreads();
      for (int tt = jb * 4 + w; tt < 1024; tt += nloc * 4) route_item(p, tt, h, lds);
      __syncthreads();
    }
    {
      const size_t nthr = (size_t)gridDim.x * 256, gtid = (size_t)blockIdx.x * 256 + tid;
      cvt_rows_fp8(p.peer_u, (unsigned char*)(p.ws + OFF_UBF), 16384ull * 1024 / 16, U_SCALE, gtid, nthr);
      cvt_rows_fp8(p.peer_v, (unsigned char*)(p.ws + OFF_VBF), 16384ull * 1024 / 16, V_SCALE, gtid, nthr);
    }
  } else if (PH == 8) {
    const int gw = blockIdx.x * 4 + w, nw = gridDim.x * 4;
    for (int tok = gw; tok < NTOK; tok += nw) expert_token<0>(p, tok, lds + w * 2048);
  } else if (PH == 14) {
    const int gw = blockIdx.x * 4 + w, nw = gridDim.x * 4;
    for (int tok = gw; tok < NTOK; tok += nw) expert_token<1>(p, tok, lds + w * 2048);
  } else if (PH == 15) {
    const int gw = blockIdx.x * 4 + w, nw = gridDim.x * 4;
    for (int tok = gw; tok < NTOK; tok += nw) expert_token<2>(p, tok, lds + w * 2048);
  } else if (PH == 9) {
    const int gw = blockIdx.x * 4 + w;
    if (gw < 64) cumsum_item(p, gw);
    const int nw9 = gridDim.x * 4;
    for (int it = nw9 - 1 - gw; it < 768; it += nw9) s5_item<0>(p, it / 3, it % 3, lds + w * 17920);
    qknorm_rows(p);
  }
}

template <int MODE>
__global__ __launch_bounds__(256, 2) void mk(Params p) {
  extern __shared__ __attribute__((aligned(16))) char lds[];
  if (MODE >= 0) {
    run_phase<MODE>(p, lds);
  } else {
    cg::grid_group grid = cg::this_grid();
    volatile LAS unsigned* st = (volatile LAS unsigned*)(lds + LDS_BYTES - 32);
    if (threadIdx.x == 0) { st[0] = 0u; st[1] = 0u; }
    __syncthreads();
    const XcdBarrier xb = xcd_barrier_post((unsigned*)(p.ws + OFF_BAR), st);
    if (p.out == nullptr) grid.sync();
    run_phase<0>(p, lds); xcd_barrier(xb);
    run_phase<1>(p, lds); xcd_barrier(xb);
    run_phase<9>(p, lds); xcd_barrier(xb);
    run_phase<2>(p, lds); xcd_barrier(xb);
    run_phase<3>(p, lds); xcd_barrier(xb);
    run_phase<4>(p, lds); xcd_barrier(xb);
    run_phase<5>(p, lds); xcd_barrier(xb);
    run_phase<6>(p, lds); xcd_barrier(xb);
    run_phase<7>(p, lds); xcd_barrier(xb);
    run_phase<8>(p, lds);
#ifdef EXPF
#if EXPF == 1
    for (int i = 0; i < 10; ++i) grid.sync();
#elif EXPF == 2
    grid.sync(); run_phase<1>(p, lds);
#endif
#endif
  }
}


template <int D>
__global__ void mk_dump(Params p) {
  const size_t n = (size_t)NTOK * 1024;
  for (size_t i = (size_t)blockIdx.x * 256 + threadIdx.x; i < n; i += (size_t)gridDim.x * 256) {
    const size_t tok = i >> 10, c = i & 1023;
    float v = 0.f;
    if (D == 1) {
#if DUMPSUB == 0
      v = bf2f(((const u16*)(p.ws + OFF_U))[tok * 512 + (c & 511)]);
#elif DUMPSUB == 1
      v = bf2f(((const u16*)(p.ws + OFF_V))[i]) + bf2f(((const u16*)(p.ws + OFF_GS))[i]) + bf2f(((const u16*)(p.ws + OFF_GA))[i]);
#elif DUMPSUB == 2
      v = bf2f(((const u16*)(p.ws + OFF_Q))[i]) + bf2f(((const u16*)(p.ws + OFF_K))[i]);
#else
      v = ((const float*)(p.ws + OFF_LOGF))[i & 262143];
#endif
    } else if (D == 11) {
      v = bf2f(((const u16*)(p.ws + OFF_Q))[i]) + bf2f(((const u16*)(p.ws + OFF_K))[i]) + bf2f(((const u16*)(p.ws + OFF_V))[i]) +
          bf2f(((const u16*)(p.ws + OFF_GS))[i]) + bf2f(((const u16*)(p.ws + OFF_GA))[i]) + bf2f(((const u16*)(p.ws + OFF_U))[tok * 512 + (c & 511)]) +
          ((const float*)(p.ws + OFF_LOGF))[i & 262143];
    } else if (D == 2) {
      v = bf2f(((const u16*)(p.ws + OFF_Q))[i]);
    } else if (D == 3) {
      v = bf2f(((const u16*)(p.ws + OFF_U))[tok * 512 + (c & 511)]);
    } else if (D == 4) {
      v = bf2f(((const u16*)(p.ws + OFF_H))[i]);
    } else if (D == 5) {
      v = bf2f(((const u16*)(p.ws + OFF_H))[i]) + bf2f(((const u16*)(p.ws + OFF_WIN))[i % (5760 * 1024)]) + bf2f(((const u16*)(p.ws + OFF_WQ))[i & (2048 * 1024 - 1)]);
    }
    p.out[i] = v;
  }
}

extern "C" void kernel_launch(void* const* d_in, const int* in_sizes, int n_in, void* d_out, int out_size, void* d_ws,
                              size_t ws_size, hipStream_t stream) {
  if (ws_size < WS_NEED) { fprintf(stderr, "workspace too small: %zu < %zu\n", ws_size, (size_t)WS_NEED); return; }
  Params p{};
  const float** f = (const float**)&p;
  for (int i = 0; i < 21; ++i) f[i] = (const float*)d_in[i];
  p.out = (float*)d_out;
  p.ws = (char*)d_ws;
#if FUSED
  static int grid_blocks = 0;
  if (!grid_blocks) {
    int dev = 0, cus = 0, per_cu = 0;
    hipGetDevice(&dev);
    hipDeviceGetAttribute(&cus, hipDeviceAttributeMultiprocessorCount, dev);
    hipFuncSetAttribute((const void*)mk<-1>, hipFuncAttributeMaxDynamicSharedMemorySize, LDS_BYTES);
    hipOccupancyMaxActiveBlocksPerMultiprocessor(&per_cu, mk<-1>, 256, LDS_BYTES);
    if (per_cu > 2) per_cu = 2;
    grid_blocks = cus * per_cu;
  }
  hipMemsetAsync((char*)d_ws + OFF_BAR, 0, XCD_BAR_WORDS * 4, stream);
  void* args[] = {&p};
  hipError_t e = hipLaunchCooperativeKernel((void*)mk<-1>, dim3(grid_blocks), dim3(256), args, LDS_BYTES, stream);
  if (e != hipSuccess) fprintf(stderr, "cooperative launch failed: %s (grid %d)\n", hipGetErrorString(e), grid_blocks);
#else
  const int G = 512;
  static bool attr_done = false;
  if (!attr_done) {
    hipFuncSetAttribute((const void*)mk<0>, hipFuncAttributeMaxDynamicSharedMemorySize, LDS_BYTES);
    hipFuncSetAttribute((const void*)mk<1>, hipFuncAttributeMaxDynamicSharedMemorySize, LDS_BYTES);
    hipFuncSetAttribute((const void*)mk<2>, hipFuncAttributeMaxDynamicSharedMemorySize, LDS_BYTES);
    hipFuncSetAttribute((const void*)mk<3>, hipFuncAttributeMaxDynamicSharedMemorySize, LDS_BYTES);
    hipFuncSetAttribute((const void*)mk<4>, hipFuncAttributeMaxDynamicSharedMemorySize, LDS_BYTES);
    hipFuncSetAttribute((const void*)mk<5>, hipFuncAttributeMaxDynamicSharedMemorySize, LDS_BYTES);
    hipFuncSetAttribute((const void*)mk<6>, hipFuncAttributeMaxDynamicSharedMemorySize, LDS_BYTES);
    hipFuncSetAttribute((const void*)mk<7>, hipFuncAttributeMaxDynamicSharedMemorySize, LDS_BYTES);
    hipFuncSetAttribute((const void*)mk<8>, hipFuncAttributeMaxDynamicSharedMemorySize, LDS_BYTES);
    hipFuncSetAttribute((const void*)mk<9>, hipFuncAttributeMaxDynamicSharedMemorySize, LDS_BYTES);
    hipFuncSetAttribute((const void*)mk<12>, hipFuncAttributeMaxDynamicSharedMemorySize, LDS_BYTES);
    hipFuncSetAttribute((const void*)mk<14>, hipFuncAttributeMaxDynamicSharedMemorySize, LDS_BYTES);
    hipFuncSetAttribute((const void*)mk<15>, hipFuncAttributeMaxDynamicSharedMemorySize, LDS_BYTES);
    hipFuncSetAttribute((const void*)mk<13>, hipFuncAttributeMaxDynamicSharedMemorySize, LDS_BYTES);
    attr_done = true;
  }
  mk<0><<<G, 256, LDS_BYTES, stream>>>(p);
#ifdef DUMP
#if DUMP == 5
  mk_dump<5><<<1024, 256, 0, stream>>>(p); return;
#endif
#endif
  mk<1><<<G, 256, LDS_BYTES, stream>>>(p);
  mk<9><<<G, 256, LDS_BYTES, stream>>>(p);
#ifdef DUMP
#if DUMP == 1
  mk_dump<1><<<1024, 256, 0, stream>>>(p); return;
#endif
#endif
  mk<2><<<G, 256, LDS_BYTES, stream>>>(p);
#ifdef DUMP
#if DUMP == 2
  mk_dump<2><<<1024, 256, 0, stream>>>(p); return;
#elif DUMP == 3
  mk_dump<3><<<1024, 256, 0, stream>>>(p); return;
#endif
#endif
  mk<3><<<G, 256, LDS_BYTES, stream>>>(p);
#ifdef DUMP
#if DUMP == 4
  mk_dump<4><<<1024, 256, 0, stream>>>(p); return;
#endif
#endif
  mk<4><<<G, 256, LDS_BYTES, stream>>>(p);
#ifndef LASTPH
#define LASTPH 8
#endif
#if LASTPH >= 5
  mk<5><<<G, 256, LDS_BYTES, stream>>>(p);
  mk<6><<<G, 256, LDS_BYTES, stream>>>(p);
  mk<7><<<G, 256, LDS_BYTES, stream>>>(p);
#endif
#if LASTPH >= 8
  mk<8><<<G, 256, LDS_BYTES, stream>>>(p);
#endif
#ifdef EXP
#if EXP == 1
  mk<4><<<G, 256, LDS_BYTES, stream>>>(p);
  mk<8><<<G, 256, LDS_BYTES, stream>>>(p);
#elif EXP == 2
  mk<1><<<G, 256, LDS_BYTES, stream>>>(p);
#elif EXP == 14
  mk<14><<<G, 256, LDS_BYTES, stream>>>(p);
#elif EXP == 15
  mk<15><<<G, 256, LDS_BYTES, stream>>>(p);
#elif EXP == 7
  mk<12><<<G, 256, LDS_BYTES, stream>>>(p);
#elif EXP == 8
  mk<13><<<G, 256, LDS_BYTES, stream>>>(p);
#elif EXP == 5
  mk<7><<<G, 256, LDS_BYTES, stream>>>(p);
#elif EXP == 6
  mk<0><<<G, 256, LDS_BYTES, stream>>>(p);
#elif EXP == 3
  mk<3><<<G, 256, LDS_BYTES, stream>>>(p);
  mk<6><<<G, 256, LDS_BYTES, stream>>>(p);
  mk<7><<<G, 256, LDS_BYTES, stream>>>(p);
#endif
#endif
#endif
}
```

```cpp
#include <hip/hip_runtime.h>
#include <hip/hip_cooperative_groups.h>
#include <stdint.h>
#include <cstdio>
namespace cg = cooperative_groups;

#ifndef FUSED
#define FUSED 1
#define LASTPH 8

#define DUMPSUB 0
#endif

#define DI __device__ __forceinline__
typedef unsigned short u16;
typedef unsigned long long u64;
using bf16x8 = __attribute__((ext_vector_type(8))) short;
using s16x4 = __attribute__((ext_vector_type(4))) short;
using f32x16 = __attribute__((ext_vector_type(16))) float;
using f32x4 = __attribute__((ext_vector_type(4))) float;

constexpr int NTOK = 32768;
constexpr float EPS = 1e-6f;

constexpr size_t MB64 = 67108864ull;
constexpr size_t OFF_WIN = 0;
constexpr size_t OFF_WGLU = OFF_WIN + 5888ull * 1024 * 2;
constexpr size_t OFF_WOUT = OFF_WGLU + 2048ull * 512 * 2;
constexpr size_t OFF_WQ = OFF_WOUT + 1024ull * 1024 * 2;
constexpr size_t OFF_SK = OFF_WQ + 2048ull * 1024 * 2;
constexpr size_t OFF_UBF = OFF_SK + 8ull * 2 * 128 * 128 * 2;
constexpr size_t OFF_VBF = OFF_UBF + 16384ull * 1024 * 2;
constexpr size_t OFF_H = OFF_VBF + 16384ull * 1024 * 2;
constexpr size_t OFF_U = OFF_H + MB64;
constexpr size_t OFF_Q = OFF_U + MB64 / 2;
constexpr size_t OFF_K = OFF_Q + MB64;
constexpr size_t OFF_V = OFF_K + MB64;
constexpr size_t OFF_GS = OFF_V + MB64;
constexpr size_t OFF_GA = OFF_GS + MB64;
constexpr size_t OFF_LOGF = OFF_GA + MB64;
constexpr size_t OFF_CUM = OFF_LOGF + 1048576;
constexpr size_t OFF_LAM = OFF_CUM + 1048576;
constexpr size_t OFF_BB = OFF_LAM + 16384;
constexpr size_t OFF_CM = OFF_BB + 131072;
constexpr size_t OFF_CTR = OFF_CM + 131072;
constexpr size_t OFF_BAR = OFF_CTR + 256;
constexpr size_t OFF_E = OFF_BAR + 16384;
constexpr size_t WS_NEED = OFF_E + 524288;

struct Params {
  const float *x, *mix_g, *w_in, *a_re, *a_im, *log_step, *b_re, *b_im, *c_re, *c_im, *ssm_d, *w_glu,
      *f_bias, *q_g, *k_g, *w_out, *ffn_g, *w_query, *sub_keys, *peer_u, *peer_v;
  float* out;
  char* ws;
};

constexpr int LDS_BYTES = 74752;

typedef __bf16 bf16v2 __attribute__((ext_vector_type(2)));
DI unsigned f2bf(float x) { return (unsigned)__builtin_bit_cast(unsigned short, (__bf16)x); }
DI unsigned pk2(float a, float b) { bf16v2 v = {(__bf16)a, (__bf16)b}; return __builtin_bit_cast(unsigned, v); }
DI float bflo(unsigned u) { return __uint_as_float(u << 16); }
DI float bfhi(unsigned u) { return __uint_as_float(u & 0xffff0000u); }
DI float bf2f(u16 b) { return __uint_as_float(((unsigned)b) << 16); }
DI f32x16 mfma32(bf16x8 a, bf16x8 b, f32x16 c) { return __builtin_amdgcn_mfma_f32_32x32x16_bf16(a, b, c, 0, 0, 0); }
DI f32x4 mfma16(bf16x8 a, bf16x8 b, f32x4 c) { return __builtin_amdgcn_mfma_f32_16x16x32_bf16(a, b, c, 0, 0, 0); }
DI float sigmoidf_(float x) { return __builtin_amdgcn_rcpf(1.f + __expf(-x)); }
DI float gelu_tanh(float x) {
  float z = 0.7978845608028654f * (x + 0.044715f * x * x * x);
  float t = 1.f - 2.f * __builtin_amdgcn_rcpf(__expf(2.f * z) + 1.f);
  return 0.5f * x * (1.f + t);
}
DI float log_sigmoid(float z) { return fminf(z, 0.f) - log1pf(__expf(-fabsf(z))); }
DI int crow(int i, int hh) { return (i & 3) + 8 * (i >> 2) + 4 * hh; }
DI uint4 ld16(const void* p) { return *(const uint4*)p; }
DI bf16x8 as_bf(uint4 v) { return __builtin_bit_cast(bf16x8, v); }
DI uint4 add_bf8(uint4 a, uint4 b) {
  uint4 o;
  o.x = pk2(bflo(a.x) + bflo(b.x), bfhi(a.x) + bfhi(b.x));
  o.y = pk2(bflo(a.y) + bflo(b.y), bfhi(a.y) + bfhi(b.y));
  o.z = pk2(bflo(a.z) + bflo(b.z), bfhi(a.z) + bfhi(b.z));
  o.w = pk2(bflo(a.w) + bflo(b.w), bfhi(a.w) + bfhi(b.w));
  return o;
}
DI unsigned srt(float f) { unsigned u = __float_as_uint(f); return (u & 0x80000000u) ? ~u : (u | 0x80000000u); }
DI float unsrt(unsigned k) { unsigned u = (k & 0x80000000u) ? (k & 0x7fffffffu) : ~k; return __uint_as_float(u); }

DI void cvt_rows8(const float* __restrict__ src, u16* __restrict__ dst, size_t n8, size_t gtid, size_t nthr) {
  const float4* s = (const float4*)src;
  uint4* d = (uint4*)dst;
  for (size_t i = gtid; i < n8; i += nthr) {
    float4 a = s[2 * i], b = s[2 * i + 1];
    uint4 o;
    o.x = pk2(a.x, a.y); o.y = pk2(a.z, a.w); o.z = pk2(b.x, b.y); o.w = pk2(b.z, b.w);
    d[i] = o;
  }
}


typedef float f32x2 __attribute__((ext_vector_type(2)));
DI void cvt_rows_fp8(const float* __restrict__ src, unsigned char* __restrict__ dst, size_t n16, float scale, size_t gtid, size_t nthr) {
  const float4* s = (const float4*)src;
  uint4* d = (uint4*)dst;
  for (size_t i = gtid; i < n16; i += nthr) {
    float4 a = s[4 * i], b = s[4 * i + 1], c = s[4 * i + 2], e = s[4 * i + 3];
    uint4 o;
    int w;
    w = __builtin_amdgcn_cvt_pk_fp8_f32(a.x * scale, a.y * scale, 0, false); w = __builtin_amdgcn_cvt_pk_fp8_f32(a.z * scale, a.w * scale, w, true); o.x = (unsigned)w;
    w = __builtin_amdgcn_cvt_pk_fp8_f32(b.x * scale, b.y * scale, 0, false); w = __builtin_amdgcn_cvt_pk_fp8_f32(b.z * scale, b.w * scale, w, true); o.y = (unsigned)w;
    w = __builtin_amdgcn_cvt_pk_fp8_f32(c.x * scale, c.y * scale, 0, false); w = __builtin_amdgcn_cvt_pk_fp8_f32(c.z * scale, c.w * scale, w, true); o.z = (unsigned)w;
    w = __builtin_amdgcn_cvt_pk_fp8_f32(e.x * scale, e.y * scale, 0, false); w = __builtin_amdgcn_cvt_pk_fp8_f32(e.z * scale, e.w * scale, w, true); o.w = (unsigned)w;
    d[i] = o;
  }
}
DI uint2 fp8x4_to_bf16x4(unsigned w) {
  const f32x2 lo = __builtin_amdgcn_cvt_pk_f32_fp8((int)w, false), hi = __builtin_amdgcn_cvt_pk_f32_fp8((int)w, true);
  uint2 o;
  o.x = __builtin_amdgcn_perm(__float_as_uint(lo[1]), __float_as_uint(lo[0]), 0x07060302u);
  o.y = __builtin_amdgcn_perm(__float_as_uint(hi[1]), __float_as_uint(hi[0]), 0x07060302u);
  return o;
}
constexpr float U_SCALE = 64.f, V_SCALE = 16.f;

template <bool WITH_F>
DI void rmsnorm_rows_t(const Params& p, const float* __restrict__ src, const float* __restrict__ g, u16* __restrict__ dst) {
  const int lane = threadIdx.x & 63;
  const int gw = blockIdx.x * 4 + (threadIdx.x >> 6), nw = gridDim.x * 4;
  float4 gv[4];
#pragma unroll
  for (int i = 0; i < 4; ++i) gv[i] = ((const float4*)g)[lane + 64 * i];
  float wf[WITH_F ? 128 : 1];
  if (WITH_F) {
#pragma unroll
    for (int i = 0; i < 4; ++i)
#pragma unroll
      for (int e = 0; e < 4; ++e) {
        const float4* wp = (const float4*)(p.w_in + (size_t)(4 * (lane + 64 * i) + e) * 5640 + 3584);
        const float4 a = wp[0], b = wp[1];
        float* d = wf + (i * 4 + e) * 8;
        d[0] = a.x; d[1] = a.y; d[2] = a.z; d[3] = a.w; d[4] = b.x; d[5] = b.y; d[6] = b.z; d[7] = b.w;
      }
  }
  for (int row = gw; row < NTOK; row += nw) {
    const float4* s = (const float4*)(src + (size_t)row * 1024);
    float4 v[4];
    float ss = 0.f;
#pragma unroll
    for (int i = 0; i < 4; ++i) {
      v[i] = s[lane + 64 * i];
      ss += v[i].x * v[i].x + v[i].y * v[i].y + v[i].z * v[i].z + v[i].w * v[i].w;
    }
#pragma unroll
    for (int d = 32; d >= 1; d >>= 1) ss += __shfl_xor(ss, d);
    const float rs = rsqrtf(ss * (1.f / 1024.f) + EPS);
    uint2* o = (uint2*)(dst + (size_t)row * 1024);
    float fd[8];
    if (WITH_F) {
#pragma unroll
      for (int h = 0; h < 8; ++h) fd[h] = 0.f;
    }
#pragma unroll
    for (int i = 0; i < 4; ++i) {
      const float y0 = v[i].x * rs * gv[i].x, y1 = v[i].y * rs * gv[i].y, y2 = v[i].z * rs * gv[i].z, y3 = v[i].w * rs * gv[i].w;
      uint2 w;
      w.x = pk2(y0, y1);
      w.y = pk2(y2, y3);
      o[lane + 64 * i] = w;
      if (WITH_F) {
#pragma unroll
        for (int h = 0; h < 8; ++h)
          fd[h] += y0 * wf[(i * 4 + 0) * 8 + h] + y1 * wf[(i * 4 + 1) * 8 + h] + y2 * wf[(i * 4 + 2) * 8 + h] + y3 * wf[(i * 4 + 3) * 8 + h];
      }
    }
    if (WITH_F) {
#pragma unroll
      for (int h = 0; h < 8; ++h)
#pragma unroll
        for (int d = 32; d >= 1; d >>= 1) fd[h] += __shfl_xor(fd[h], d);
      float mine = fd[0];
#pragma unroll
      for (int h = 1; h < 8; ++h) mine = (lane == h) ? fd[h] : mine;
      if (lane < 8) {
        const int b = row >> 12, l = row & 4095;
        ((float*)(p.ws + OFF_LOGF))[(size_t)(b * 8 + lane) * 4096 + l] = log_sigmoid(mine + p.f_bias[lane]);
      }
    }
  }
}

DI int srccol(int mat, int n) {
  if (mat == 0) {
    if (n < 3584) return n;
    if (n < 5632) return n + 8;
    return -1;
  }
  if (mat == 1) {
    int c = n >> 6, wi = n & 63;
    return wi < 32 ? 32 * c + wi : 1024 + 32 * c + wi - 32;
  }
  return n;
}

DI void transpose_tile(const float* __restrict__ src, int Nsrc, int K, u16* __restrict__ dst, int k0, int n0, int mat, float* tl) {
  const int tid = threadIdx.x, c = tid & 63, r0 = tid >> 6;
  const int sc = srccol(mat, n0 + c);
#pragma unroll
  for (int i = 0; i < 16; ++i) {
    int rr = r0 + 4 * i;
    float v = sc >= 0 ? src[(size_t)(k0 + rr) * Nsrc + sc] : 0.f;
    tl[c * 65 + rr] = v;
  }
  __syncthreads();
  const int kk = (tid & 31) * 2, c0 = tid >> 5;
#pragma unroll
  for (int i = 0; i < 8; ++i) {
    int cc = c0 + 8 * i;
    unsigned o = pk2(tl[cc * 65 + kk], tl[cc * 65 + kk + 1]);
    *(unsigned*)(dst + (size_t)(n0 + cc) * K + k0 + kk) = o;
  }
  __syncthreads();
}

DI void phase_prep(const Params& p, char* lds) {
  const int tid = threadIdx.x;
  const size_t nthr = (size_t)gridDim.x * 256, gtid = (size_t)blockIdx.x * 256 + tid;
  if (gtid == 0) {
    int* ctr = (int*)(p.ws + OFF_CTR);
    for (int i = 0; i < 16; ++i) ctr[i] = 0;
  }
  if (gtid < 2048) {
    const int g = (int)gtid >> 6, pp = (int)gtid & 63;
    const float step = expf(p.log_step[g]);
    const float ar = p.a_re[g * 64 + pp], ai = p.a_im[g * 64 + pp];
    const float mag = expf(ar * step);
    const float lr = mag * cosf(ai * step), li = mag * sinf(ai * step);
    const float nr = lr - 1.f, ni = li, den = ar * ar + ai * ai;
    const float cr = (nr * ar + ni * ai) / den, ci = (ni * ar - nr * ai) / den;
    float* lam = (float*)(p.ws + OFF_LAM);
    lam[(g * 64 + pp) * 2] = lr;
    lam[(g * 64 + pp) * 2 + 1] = li;
    u16* bb = (u16*)(p.ws + OFF_BB);
    u16* cm = (u16*)(p.ws + OFF_CM);
    for (int h = 0; h < 16; ++h) {
      float bre = p.b_re[(g * 64 + pp) * 16 + h], bim = p.b_im[(g * 64 + pp) * 16 + h];
      bb[(g * 128 + pp) * 16 + h] = (u16)f2bf(cr * bre - ci * bim);
      bb[(g * 128 + 64 + pp) * 16 + h] = (u16)f2bf(cr * bim + ci * bre);
      cm[(g * 16 + h) * 128 + pp] = (u16)f2bf(p.c_re[(g * 16 + h) * 64 + pp]);
      cm[(g * 16 + h) * 128 + 64 + pp] = (u16)f2bf(-p.c_im[(g * 16 + h) * 64 + pp]);
    }
  }
  {
    float* tl = (float*)lds;
    for (int t = blockIdx.x; t < 2432; t += gridDim.x) {
      if (t < 1408) {
        int kt = t % 16, nt = t / 16;
        transpose_tile(p.w_in, 5640, 1024, (u16*)(p.ws + OFF_WIN), kt * 64, nt * 64, 0, tl);
      } else if (t < 1664) {
        int u = t - 1408, kt = u % 8, nt = u / 8;
        transpose_tile(p.w_glu, 2048, 512, (u16*)(p.ws + OFF_WGLU), kt * 64, nt * 64, 1, tl);
      } else if (t < 1920) {
        int u = t - 1664, kt = u % 16, nt = u / 16;
        transpose_tile(p.w_out, 1024, 1024, (u16*)(p.ws + OFF_WOUT), kt * 64, nt * 64, 2, tl);
      } else {
        int u = t - 1920, kt = u % 16, nt = u / 16;
        transpose_tile(p.w_query, 2048, 1024, (u16*)(p.ws + OFF_WQ), kt * 64, nt * 64, 3, tl);
      }
    }
  }
  rmsnorm_rows_t<true>(p, p.x, p.mix_g, (u16*)(p.ws + OFF_H));
  cvt_rows8(p.sub_keys, (u16*)(p.ws + OFF_SK), 8ull * 2 * 128 * 128 / 8, gtid, nthr);

}

enum { G_INPROJ = 0, G_GLU = 1, G_OUT = 2, G_PQ = 3 };

#define RAW_BARRIER() do { asm volatile("s_waitcnt lgkmcnt(0)" ::: "memory"); __builtin_amdgcn_s_barrier(); asm volatile("" ::: "memory"); } while (0)

template <int K, int MODE>
DI void gemm_tile(const Params& p, const u16* __restrict__ A, const u16* __restrict__ W, int mt, int nt, char* lds) {
  constexpr int WB = 256 * 64, AB = 128 * 64, SB = WB + AB;
  constexpr int NK = K / 32;
  const int tid = threadIdx.x, lane = tid & 63, w = tid >> 6, wn = w >> 1, wm = w & 1, r = lane & 31, hh = lane >> 5;
  const int lrow = tid >> 2, gc = (tid & 3) ^ ((tid >> 4) & 3);
  const u16* gW = W + (size_t)(nt * 256 + lrow) * K + gc * 8;
  const u16* gA = A + (size_t)(mt * 128 + lrow) * K + gc * 8;
  f32x16 acc[4][2];
#pragma unroll
  for (int a = 0; a < 4; ++a)
#pragma unroll
    for (int b = 0; b < 2; ++b)
#pragma unroll
      for (int i = 0; i < 16; ++i) acc[a][b][i] = 0.f;
  auto issue = [&](int kt, int st) {
    char* base = lds + st * SB + tid * 16;
#pragma unroll
    for (int i = 0; i < 4; ++i)
      __builtin_amdgcn_global_load_lds((const unsigned*)(gW + (size_t)(64 * i) * K + kt * 32),
                                       (__attribute__((address_space(3))) unsigned*)(base + i * 4096), 16, 0, 0);
#pragma unroll
    for (int i = 0; i < 2; ++i)
      __builtin_amdgcn_global_load_lds((const unsigned*)(gA + (size_t)(64 * i) * K + kt * 32),
                                       (__attribute__((address_space(3))) unsigned*)(base + WB + i * 4096), 16, 0, 0);
  };
  const int sw = (r >> 2) & 3;
  asm volatile("s_waitcnt vmcnt(0)" ::: "memory");
  RAW_BARRIER();
  issue(0, 0); issue(1, 1);
  int cs = 0, ls = 2;
  for (int kt = 0; kt < NK; ++kt) {
    if (kt + 1 < NK) asm volatile("s_waitcnt vmcnt(6)" ::: "memory");
    else asm volatile("s_waitcnt vmcnt(0)" ::: "memory");
    RAW_BARRIER();
    if (kt + 2 < NK) issue(kt + 2, ls);
    const char* lw = lds + cs * SB + (wn * 128 + r) * 64;
    const char* la = lds + cs * SB + WB + (wm * 64 + r) * 64;
#pragma unroll
    for (int s = 0; s < 2; ++s) {
      bf16x8 fw[4], fa[2];
      const int po = ((2 * s + hh) ^ sw) * 16;
#pragma unroll
      for (int j = 0; j < 4; ++j) fw[j] = *(const bf16x8*)(lw + j * 32 * 64 + po);
#pragma unroll
      for (int j = 0; j < 2; ++j) fa[j] = *(const bf16x8*)(la + j * 32 * 64 + po);
#pragma unroll
      for (int nb = 0; nb < 4; ++nb)
#pragma unroll
        for (int mb = 0; mb < 2; ++mb) acc[nb][mb] = mfma32(fw[nb], fa[mb], acc[nb][mb]);
    }
    cs = cs == 2 ? 0 : cs + 1;
    ls = ls == 2 ? 0 : ls + 1;
  }
  const int mbase = mt * 128 + wm * 64 + r;
  const int nc = 2 * nt + wn;
  if (MODE == G_INPROJ) {
    const bool isq = (nc >= 4 && nc < 12);
#pragma unroll
    for (int nb = 0; nb < 4; ++nb)
#pragma unroll
      for (int mb = 0; mb < 2; ++mb)
#pragma unroll
        for (int ig = 0; ig < 4; ++ig) {
          const int nl = nb * 32 + ig * 8 + hh * 4;
          const int m = mbase + mb * 32;
          float v0 = acc[nb][mb][4 * ig], v1 = acc[nb][mb][4 * ig + 1], v2 = acc[nb][mb][4 * ig + 2], v3 = acc[nb][mb][4 * ig + 3];
          if (nc < 4) {
            uint2 o; o.x = pk2(v0, v1); o.y = pk2(v2, v3);
            *(uint2*)((u16*)(p.ws + OFF_U) + (size_t)m * 512 + nc * 128 + nl) = o;
          } else if (nc < 20) {
            uint2 o; o.x = pk2(v0, v1); o.y = pk2(v2, v3);
            size_t off = isq ? OFF_Q : OFF_K;
            int hd = isq ? nc - 4 : nc - 12;
            *(uint2*)((u16*)(p.ws + off) + (size_t)m * 1024 + hd * 128 + nl) = o;
          } else if (nc < 28) {
            uint2 o; o.x = pk2(v0, v1); o.y = pk2(v2, v3);
            *(uint2*)((u16*)(p.ws + OFF_V) + (size_t)m * 1024 + (nc - 20) * 128 + nl) = o;
          } else if (nc < 44) {
            uint2 o; o.x = pk2(sigmoidf_(v0), sigmoidf_(v1)); o.y = pk2(sigmoidf_(v2), sigmoidf_(v3));
            size_t off = nc < 36 ? OFF_GS : OFF_GA;
            int cb = nc < 36 ? nc - 28 : nc - 36;
            *(uint2*)((u16*)(p.ws + off) + (size_t)m * 1024 + cb * 128 + nl) = o;
          } else if (nc == 44) {
            if (nb == 0 && ig == 0) {
              const int b = m >> 12, l = m & 4095;
              float* lf = (float*)(p.ws + OFF_LOGF);
              const int h0 = hh * 4;
              lf[(size_t)(b * 8 + h0 + 0) * 4096 + l] = log_sigmoid(v0 + p.f_bias[h0 + 0]);
              lf[(size_t)(b * 8 + h0 + 1) * 4096 + l] = log_sigmoid(v1 + p.f_bias[h0 + 1]);
              lf[(size_t)(b * 8 + h0 + 2) * 4096 + l] = log_sigmoid(v2 + p.f_bias[h0 + 2]);
              lf[(size_t)(b * 8 + h0 + 3) * 4096 + l] = log_sigmoid(v3 + p.f_bias[h0 + 3]);
            }
          }
        }
  } else if (MODE == G_GLU) {
#pragma unroll
    for (int j = 0; j < 2; ++j)
#pragma unroll
      for (int mb = 0; mb < 2; ++mb)
#pragma unroll
        for (int ig = 0; ig < 4; ++ig) {
          const int c = 2 * nc + j;
          const int n = 32 * c + ig * 8 + hh * 4;
          const int m = mbase + mb * 32;
          uint2 gs = *(const uint2*)((const u16*)(p.ws + OFF_GS) + (size_t)m * 1024 + n);
          uint2 ma = *(const uint2*)((const u16*)(p.ws + OFF_Q) + (size_t)m * 1024 + n);
          float y0 = acc[2 * j][mb][4 * ig] * sigmoidf_(acc[2 * j + 1][mb][4 * ig]) * bflo(gs.x) + bflo(ma.x);
          float y1 = acc[2 * j][mb][4 * ig + 1] * sigmoidf_(acc[2 * j + 1][mb][4 * ig + 1]) * bfhi(gs.x) + bfhi(ma.x);
          float y2 = acc[2 * j][mb][4 * ig + 2] * sigmoidf_(acc[2 * j + 1][mb][4 * ig + 2]) * bflo(gs.y) + bflo(ma.y);
          float y3 = acc[2 * j][mb][4 * ig + 3] * sigmoidf_(acc[2 * j + 1][mb][4 * ig + 3]) * bfhi(gs.y) + bfhi(ma.y);
          uint2 o; o.x = pk2(y0, y1); o.y = pk2(y2, y3);
          *(uint2*)((u16*)(p.ws + OFF_H) + (size_t)m * 1024 + n) = o;
        }
  } else {
#pragma unroll
    for (int nb = 0; nb < 4; ++nb)
#pragma unroll
      for (int mb = 0; mb < 2; ++mb)
#pragma unroll
        for (int ig = 0; ig < 4; ++ig) {
          const int n = nc * 128 + nb * 32 + ig * 8 + hh * 4;
          const int m = mbase + mb * 32;
          float v0 = acc[nb][mb][4 * ig], v1 = acc[nb][mb][4 * ig + 1], v2 = acc[nb][mb][4 * ig + 2], v3 = acc[nb][mb][4 * ig + 3];
          if (MODE == G_OUT) {
            float4 xv = *(const float4*)(p.x + (size_t)m * 1024 + n);
            xv.x += v0; xv.y += v1; xv.z += v2; xv.w += v3;
            *(float4*)(p.out + (size_t)m * 1024 + n) = xv;
          } else {
            uint2 o; o.x = pk2(v0, v1); o.y = pk2(v2, v3);
            *(uint2*)((u16*)(p.ws + OFF_V) + (size_t)m * 2048 + n) = o;
          }
        }
  }
}

DI void qknorm_rows(const Params& p) {
  const int lane = threadIdx.x & 63;
  const int gw = blockIdx.x * 4 + (threadIdx.x >> 6), nw = gridDim.x * 4;
  const int d0 = (lane & 7) * 16;
  for (int it0 = gw; it0 < 2 * NTOK; it0 += 4 * nw) {
    uint4 ra[4], rb[4];
    u16* bases[4];
#pragma unroll
    for (int j = 0; j < 4; ++j) {
      const int it = it0 + j * nw;
      const int itc = it < 2 * NTOK ? it : it0;
      const int isk = itc >= NTOK;
      const int row = isk ? itc - NTOK : itc;
      bases[j] = (u16*)(p.ws + (isk ? OFF_K : OFF_Q)) + (size_t)row * 1024 + lane * 16;
      ra[j] = ld16(bases[j]); rb[j] = ld16(bases[j] + 8);
    }
#pragma unroll
    for (int j = 0; j < 4; ++j) {
      const int it = it0 + j * nw;
      if (it >= 2 * NTOK) break;
      const int isk = it >= NTOK;
      const float* g = (isk ? p.k_g : p.q_g) + d0;
      const uint4 a = ra[j], b = rb[j];
      float v[16];
      v[0] = bflo(a.x); v[1] = bfhi(a.x); v[2] = bflo(a.y); v[3] = bfhi(a.y); v[4] = bflo(a.z); v[5] = bfhi(a.z); v[6] = bflo(a.w); v[7] = bfhi(a.w);
      v[8] = bflo(b.x); v[9] = bfhi(b.x); v[10] = bflo(b.y); v[11] = bfhi(b.y); v[12] = bflo(b.z); v[13] = bfhi(b.z); v[14] = bflo(b.w); v[15] = bfhi(b.w);
      float ss = 0.f;
#pragma unroll
      for (int i = 0; i < 16; ++i) ss += v[i] * v[i];
      ss += __shfl_xor(ss, 1); ss += __shfl_xor(ss, 2); ss += __shfl_xor(ss, 4);
      const float rs = rsqrtf(ss * (1.f / 128.f) + EPS) * (isk ? 1.f : 0.08838834764831845f * 1.4426950408889634f);
#pragma unroll
      for (int i = 0; i < 16; ++i) v[i] *= rs * g[i];
      uint4 oa, ob;
      oa.x = pk2(v[0], v[1]); oa.y = pk2(v[2], v[3]); oa.z = pk2(v[4], v[5]); oa.w = pk2(v[6], v[7]);
      ob.x = pk2(v[8], v[9]); ob.y = pk2(v[10], v[11]); ob.z = pk2(v[12], v[13]); ob.w = pk2(v[14], v[15]);
      *(uint4*)bases[j] = oa; *(uint4*)(bases[j] + 8) = ob;
    }
  }
}

template <int MODE>
DI void s5_item(const Params& p, int bg, int seg, char* ldsw) {
  const int lane = threadIdx.x & 63, r = lane & 31, hh = lane >> 5, c15 = lane & 15, quad = lane >> 4;
  const int b = bg >> 5, g = bg & 31;
  float* X = (float*)ldsw;
  const u16* bbp = (const u16*)(p.ws + OFF_BB);
  const u16* cmp = (const u16*)(p.ws + OFF_CM);
  bf16x8 Bf[4], Cf[4];
#pragma unroll
  for (int nb = 0; nb < 4; ++nb) Bf[nb] = as_bf(ld16(bbp + (g * 128 + nb * 32 + r) * 16 + hh * 8));
#pragma unroll
  for (int ks = 0; ks < 4; ++ks) Cf[ks] = as_bf(ld16(cmp + (g * 16 + c15) * 128 + ks * 32 + quad * 8));
  const float* lam = (const float*)(p.ws + OFF_LAM);
  const float lr = lam[(g * 64 + lane) * 2], li = lam[(g * 64 + lane) * 2 + 1];
  const float dsk = p.ssm_d[g * 16 + c15];
  u16* ub = (u16*)(p.ws + OFF_U) + (size_t)b * 4096 * 512 + g * 16;
  float sr = 0.f, si = 0.f;
  float2* Eg = (float2*)(p.ws + OFF_E) + (size_t)bg * 256;
  if (MODE == 1 && seg > 0) {
    float pr = lr, pi = li;
#pragma unroll
    for (int i = 0; i < 10; ++i) { const float nr = pr * pr - pi * pi, ni = 2.f * pr * pi; pr = nr; pi = ni; }
    for (int k = 0; k < seg; ++k) {
      const float2 e = Eg[k * 64 + lane];
      const float nr = pr * sr - pi * si + e.x, ni = pr * si + pi * sr + e.y;
      sr = nr; si = ni;
    }
  }
  const int cbeg = seg * 32;
  u16* Ul = (u16*)(ldsw + 16896);
  uint4 a_next = ld16(ub + (size_t)(cbeg * 32 + r) * 512 + hh * 8);
#pragma unroll 1
  for (int c = cbeg; c < cbeg + 32; ++c) {
    const int t0 = c * 32;
    const bf16x8 a = as_bf(a_next);
    if (MODE == 1) *(uint4*)(Ul + r * 16 + hh * 8) = a_next;
    if (c + 1 < cbeg + 32) a_next = ld16(ub + (size_t)((c + 1) * 32 + r) * 512 + hh * 8);
#pragma unroll
    for (int nb = 0; nb < 4; ++nb) {
      f32x16 z;
#pragma unroll
      for (int i = 0; i < 16; ++i) z[i] = 0.f;
      z = mfma32(a, Bf[nb], z);
#pragma unroll
      for (int i = 0; i < 16; ++i) X[crow(i, hh) * 132 + nb * 32 + r] = z[i];
    }
    __builtin_amdgcn_fence(__ATOMIC_RELEASE, "wavefront");
    __builtin_amdgcn_wave_barrier();
    __builtin_amdgcn_fence(__ATOMIC_ACQUIRE, "wavefront");
    float xr[32], xi[32];
#pragma unroll
    for (int t = 0; t < 32; ++t) { xr[t] = X[t * 132 + lane]; xi[t] = X[t * 132 + 64 + lane]; }
#pragma unroll
    for (int t = 0; t < 32; ++t) {
      float nsr = lr * sr - li * si + xr[t];
      float nsi = lr * si + li * sr + xi[t];
      sr = nsr; si = nsi;
      xr[t] = sr; xi[t] = si;
    }
    if (MODE == 1) {
#pragma unroll
    for (int t = 0; t < 32; ++t) { X[t * 132 + lane] = xr[t]; X[t * 132 + 64 + lane] = xi[t]; }
    __builtin_amdgcn_fence(__ATOMIC_RELEASE, "wavefront");
    __builtin_amdgcn_wave_barrier();
    __builtin_amdgcn_fence(__ATOMIC_ACQUIRE, "wavefront");
#pragma unroll
    for (int mb = 0; mb < 2; ++mb) {
      f32x4 y = {0.f, 0.f, 0.f, 0.f};
#pragma unroll
      for (int ks = 0; ks < 4; ++ks) {
        const float4 s0 = *(const float4*)(X + (16 * mb + c15) * 132 + ks * 32 + quad * 8);
        const float4 s1 = *(const float4*)(X + (16 * mb + c15) * 132 + ks * 32 + quad * 8 + 4);
        uint4 pk; pk.x = pk2(s0.x, s0.y); pk.y = pk2(s0.z, s0.w); pk.z = pk2(s1.x, s1.y); pk.w = pk2(s1.z, s1.w);
        y = mfma16(as_bf(pk), Cf[ks], y);
      }
#pragma unroll
      for (int j = 0; j < 4; ++j) {
        const int t = t0 + 16 * mb + 4 * quad + j;
        float yy = y[j] + dsk * bf2f(Ul[(16 * mb + 4 * quad + j) * 16 + c15]);
        ub[(size_t)t * 512 + c15] = (u16)f2bf(gelu_tanh(yy));
      }
    }
    }
    __builtin_amdgcn_fence(__ATOMIC_RELEASE, "wavefront");
    __builtin_amdgcn_wave_barrier();
    __builtin_amdgcn_fence(__ATOMIC_ACQUIRE, "wavefront");
  }
  if (MODE == 0) Eg[seg * 64 + lane] = make_float2(sr, si);
}


DI void cumsum_item(const Params& p, int bh) {
  const int lane = threadIdx.x & 63;
  const float4* lf = (const float4*)((const float*)(p.ws + OFF_LOGF) + (size_t)bh * 4096 + lane * 64);
  float4* co = (float4*)((float*)(p.ws + OFF_CUM) + (size_t)bh * 4096 + lane * 64);
  float run = 0.f;
  float4 v[16];
#pragma unroll
  for (int i = 0; i < 16; ++i) {
    float4 t = lf[i];
    t.x *= 1.4426950408889634f; t.y *= 1.4426950408889634f; t.z *= 1.4426950408889634f; t.w *= 1.4426950408889634f;
    t.x += run; t.y += t.x; t.z += t.y; t.w += t.z; run = t.w;
    v[i] = t;
  }
  float inc = run;
#pragma unroll
  for (int d = 1; d < 64; d <<= 1) { float t = __shfl_up(inc, d); if (lane >= d) inc += t; }
  const float off = inc - run;
#pragma unroll
  for (int i = 0; i < 16; ++i) { float4 t = v[i]; t.x += off; t.y += off; t.z += off; t.w += off; co[i] = t; }
}


DI void dma16(const void* g, unsigned lds_off) {
  asm volatile("s_mov_b32 m0, %0\n\ts_nop 0\n\tglobal_load_lds_dwordx4 %1, off" :: "s"(__builtin_amdgcn_readfirstlane(lds_off)), "v"(g) : "memory", "m0");
}
DI void dma4(const void* g, unsigned lds_off) {
  asm volatile("s_mov_b32 m0, %0\n\ts_nop 0\n\tglobal_load_lds_dword %1, off" :: "s"(__builtin_amdgcn_readfirstlane(lds_off)), "v"(g) : "memory", "m0");
}

DI void attn_item(const Params& p, int bh, int qb, char* lds) {
  constexpr int OPB = 32 * 256, SB = 2 * OPB;
  const int tid = threadIdx.x, lane = tid & 63, w = tid >> 6, r = lane & 31, hh = lane >> 5;
  float* cumS = (float*)(lds + 4 * SB) + w * 64;
  const int b = bh >> 3, h = bh & 7;
  const size_t tokbase = (size_t)b * 4096;
  const float* cumg = (const float*)(p.ws + OFF_CUM) + (size_t)bh * 4096;
  const int q0 = qb * 128;
  const int myq = q0 + 32 * w + r;
  const u16* Qg = (const u16*)(p.ws + OFF_Q) + (tokbase + myq) * 1024 + h * 128 + hh * 8;
  bf16x8 Qf[8];
#pragma unroll
  for (int s = 0; s < 8; ++s) Qf[s] = as_bf(ld16(Qg + s * 16));
  const float cq = cumg[myq];
  const int nkt = 4 * qb + 4;
  int kt0;
  {
    float gq = fmaxf(fabsf(p.q_g[lane]), fabsf(p.q_g[lane + 64])), gk = fmaxf(fabsf(p.k_g[lane]), fabsf(p.k_g[lane + 64]));
#pragma unroll
    for (int d = 32; d >= 1; d >>= 1) { gq = fmaxf(gq, __shfl_xor(gq, d)); gk = fmaxf(gk, __shfl_xor(gk, d)); }
    const float thr = -(40.f + 2.f * 1.01f * 11.313708499f * 1.4426950408889634f * gq * gk);
    const float c0 = cumg[q0];
    int* kmin = (int*)(lds + LDS_BYTES - 48);
    __syncthreads();
    if (tid == 0) *kmin = 4 * qb;
    __syncthreads();
    for (int t = tid; t < 4 * qb; t += 256)
      if (c0 - cumg[32 * t + 31] >= thr) atomicMin(kmin, t);
    __syncthreads();
    kt0 = *kmin;
  }
  const int lrow = tid >> 4;
  const int gcK = (tid & 15) ^ ((tid >> 4) & 15);
  const int gcV = (tid & 15) ^ (((tid >> 4) & 3) << 1);
  const u16* Kg = (const u16*)(p.ws + OFF_K) + (tokbase + lrow) * 1024 + h * 128 + gcK * 8;
  const u16* Vg = (const u16*)(p.ws + OFF_V) + (tokbase + lrow) * 1024 + h * 128 + gcV * 8;
  const unsigned lds0 = (unsigned)(size_t)lds;
  auto issue = [&](int kt) {
    const unsigned base = lds0 + (kt & 3) * SB + w * 1024;
#pragma unroll
    for (int i = 0; i < 2; ++i) {
      dma16(Kg + (size_t)(kt * 32 + 16 * i) * 1024, base + i * 4096);
      dma16(Vg + (size_t)(kt * 32 + 16 * i) * 1024, base + OPB + i * 4096);
    }
    dma4(cumg + kt * 32 + lane, lds0 + 4 * SB + (w * 64 + (kt & 3) * 256) * 4);
  };
  f32x16 oacc[4];
#pragma unroll
  for (int d = 0; d < 4; ++d)
#pragma unroll
    for (int i = 0; i < 16; ++i) oacc[d][i] = 0.f;
  float mrun = -INFINITY, lsum = 0.f;
  const int i16 = lane & 15, q4 = i16 >> 2, p4 = i16 & 3, blk = (lane >> 4) & 1;
  const int ksw = r & 15;
  asm volatile("s_waitcnt vmcnt(0)" ::: "memory");
  RAW_BARRIER();
  issue(kt0); issue(kt0 + 1); issue(kt0 + 2);
  auto compute = [&](int kt) {
    const char* Kl = lds + (kt & 3) * SB;
    const char* Vl = Kl + OPB;
    const float* cS = cumS + (kt & 3) * 256;
    f32x16 sacc;
#pragma unroll
    for (int ig = 0; ig < 4; ++ig) {
      const float4 ck = *(const float4*)(cS + 8 * ig + 4 * hh);
      sacc[4 * ig] = cq - ck.x; sacc[4 * ig + 1] = cq - ck.y; sacc[4 * ig + 2] = cq - ck.z; sacc[4 * ig + 3] = cq - ck.w;
    }
#pragma unroll
    for (int s = 0; s < 8; ++s) {
      bf16x8 kf = *(const bf16x8*)(Kl + r * 256 + (((2 * s + hh) ^ ksw) * 16));
      sacc = mfma32(kf, Qf[s], sacc);
    }
    if (kt >= 4 * qb) {
#pragma unroll
      for (int i = 0; i < 16; ++i) {
        const int key = kt * 32 + crow(i, hh);
        if (key > myq) sacc[i] = -INFINITY;
      }
    }
    float mx = sacc[0];
#pragma unroll
    for (int i = 1; i < 16; ++i) mx = fmaxf(mx, sacc[i]);
    mx = fmaxf(mx, __shfl_xor(mx, 32));
    if (__builtin_amdgcn_ballot_w64(mx > mrun + 20.f) != 0ull) {
      const float mnew = fmaxf(mrun, mx);
      const float alpha = __builtin_amdgcn_exp2f(mrun - mnew);
      mrun = mnew;
      lsum *= alpha;
#pragma unroll
      for (int d = 0; d < 4; ++d)
#pragma unroll
        for (int i = 0; i < 16; ++i) oacc[d][i] *= alpha;
    }
    float ps = 0.f;
#pragma unroll
    for (int i = 0; i < 16; ++i) {
      float e = __builtin_amdgcn_exp2f(sacc[i] - mrun);
      sacc[i] = e;
      ps += e;
    }
    lsum += ps;
#pragma unroll
    for (int sp = 0; sp < 2; ++sp) {
      uint4 pk;
      pk.x = pk2(sacc[8 * sp], sacc[8 * sp + 1]);
      pk.y = pk2(sacc[8 * sp + 2], sacc[8 * sp + 3]);
      pk.z = pk2(sacc[8 * sp + 4], sacc[8 * sp + 5]);
      pk.w = pk2(sacc[8 * sp + 6], sacc[8 * sp + 7]);
      const bf16x8 pf = as_bf(pk);
      const char* vrow = Vl + (16 * sp + 4 * hh + q4) * 256 + (p4 & 1) * 8;
#pragma unroll
      for (int db = 0; db < 4; ++db) {
        const int po = ((4 * db + 2 * blk + (p4 >> 1)) ^ (q4 << 1)) * 16;
        s16x4 lo = __builtin_amdgcn_ds_read_tr16_b64_v4i16((__attribute__((address_space(3))) s16x4*)(vrow + po));
        s16x4 hi = __builtin_amdgcn_ds_read_tr16_b64_v4i16((__attribute__((address_space(3))) s16x4*)(vrow + 8 * 256 + po));
        bf16x8 vf = __builtin_shufflevector(lo, hi, 0, 1, 2, 3, 4, 5, 6, 7);
        oacc[db] = mfma32(vf, pf, oacc[db]);
      }
    }
  };
  for (int kt = kt0; kt < nkt; ++kt) {
    if (kt + 2 < nkt) asm volatile("s_waitcnt vmcnt(10)" ::: "memory");
    else if (kt + 1 < nkt) asm volatile("s_waitcnt vmcnt(5)" ::: "memory");
    else asm volatile("s_waitcnt vmcnt(0)" ::: "memory");
    RAW_BARRIER();
    if (kt + 3 < nkt) issue(kt + 3);
    compute(kt);
  }
  const float ltot = lsum + __shfl_xor(lsum, 32);
  const float inv = 1.f / ltot;
  const u16* gag = (const u16*)(p.ws + OFF_GA) + (tokbase + myq) * 1024 + h * 128;
  u16* og = (u16*)(p.ws + OFF_Q) + (tokbase + myq) * 1024 + h * 128;
#pragma unroll
  for (int db = 0; db < 4; ++db)
#pragma unroll
    for (int ig = 0; ig < 4; ++ig) {
      const int d = 32 * db + 8 * ig + 4 * hh;
      uint2 ga = *(const uint2*)(gag + d);
      uint2 o;
      o.x = pk2(oacc[db][4 * ig] * inv * bflo(ga.x), oacc[db][4 * ig + 1] * inv * bfhi(ga.x));
      o.y = pk2(oacc[db][4 * ig + 2] * inv * bflo(ga.y), oacc[db][4 * ig + 3] * inv * bfhi(ga.y));
      *(uint2*)(og + d) = o;
    }
}

DI void ins32(unsigned (&L)[16], unsigned k) {
#pragma unroll
  for (int j = 0; j < 16; ++j) {
    unsigned hi = L[j] > k ? L[j] : k;
    k = L[j] > k ? k : L[j];
    L[j] = hi;
  }
}
DI void ins64(u64 (&M)[16], u64 k) {
#pragma unroll
  for (int j = 0; j < 16; ++j) {
    const bool gt = k > M[j];
    const u64 hi = gt ? k : M[j];
    const u64 lo = gt ? M[j] : k;
    M[j] = hi;
    k = lo;
  }
}


DI void cex_desc(unsigned& a, unsigned& b) { const unsigned hi = a > b ? a : b, lo = a > b ? b : a; a = hi; b = lo; }
DI void bitonic_sort16_desc(unsigned (&v)[16]) {
#pragma unroll
  for (int k = 2; k <= 16; k <<= 1)
#pragma unroll
    for (int j = k >> 1; j >= 1; j >>= 1)
#pragma unroll
      for (int i = 0; i < 16; ++i) {
        const int l = i ^ j;
        if (l > i) {
          if ((i & k) == 0) cex_desc(v[i], v[l]);
          else cex_desc(v[l], v[i]);
        }
      }
}
DI void merge_top16_desc(unsigned (&a)[16], const unsigned (&b)[16]) {
#pragma unroll
  for (int i = 0; i < 16; ++i) a[i] = a[i] > b[15 - i] ? a[i] : b[15 - i];
#pragma unroll
  for (int j = 8; j >= 1; j >>= 1)
#pragma unroll
    for (int i = 0; i < 16; ++i) {
      const int l = i ^ j;
      if (l > i) cex_desc(a[i], a[l]);
    }
}

DI void route_item(const Params& p, int tt, int h, const char* skl) {
  const int lane = threadIdx.x & 63, r = lane & 31, hh = lane >> 5;
  const int tok = tt * 32 + r;
  const u16* pq = (const u16*)(p.ws + OFF_V) + (size_t)tok * 2048 + h * 256 + hh * 8;
  uint4 bqv[16];
#pragma unroll
  for (int i = 0; i < 16; ++i) bqv[i] = ld16(pq + (i >> 3) * 128 + (i & 7) * 16);
  const char* skr = skl + r * 256;
  const int ksw = r & 15;
  unsigned L[2][16];
  const unsigned hsel = (unsigned)hh << 2;
#pragma unroll
  for (int c = 0; c < 2; ++c) {
    f32x16 acc[4];
#pragma unroll
    for (int kb = 0; kb < 4; ++kb)
#pragma unroll
      for (int i = 0; i < 16; ++i) acc[kb][i] = 0.f;
#pragma unroll
    for (int s = 0; s < 8; ++s) {
      const bf16x8 bq = as_bf(bqv[c * 8 + s]);
#pragma unroll
      for (int kb = 0; kb < 4; ++kb) {
        const bf16x8 ak = *(const bf16x8*)(skr + (c * 128 + kb * 32) * 256 + (((2 * s + hh) ^ ksw) * 16));
        acc[kb] = mfma32(ak, bq, acc[kb]);
      }
      __builtin_amdgcn_sched_barrier(0);
    }
#pragma unroll
    for (int kb = 0; kb < 4; ++kb) {
      unsigned G[16];
#pragma unroll
      for (int i = 0; i < 16; ++i) G[i] = (srt(acc[kb][i]) & ~127u) | (unsigned)(127 - (32 * kb + crow(i, 0)));
      bitonic_sort16_desc(G);
      if (kb == 0) {
#pragma unroll
        for (int i = 0; i < 16; ++i) L[c][i] = G[i];
      } else {
        merge_top16_desc(L[c], G);
      }
      __builtin_amdgcn_sched_barrier(0);
    }
    unsigned P[16];
#pragma unroll
    for (int j = 0; j < 16; ++j) { L[c][j] ^= hsel; P[j] = (unsigned)__shfl_xor((int)L[c][j], 32); }
    merge_top16_desc(L[c], P);
  }
  float s0[16], s1[16];
  unsigned W0[4] = {0u, 0u, 0u, 0u}, W1[4] = {0u, 0u, 0u, 0u};
#pragma unroll
  for (int j = 0; j < 16; ++j) {
    s0[j] = unsrt(L[0][j] & ~127u);
    s1[j] = unsrt(L[1][j] & ~127u);
    W0[j >> 2] |= (127u - (L[0][j] & 127u)) << (8 * (j & 3));
    W1[j >> 2] |= (127u - (L[1][j] & 127u)) << (8 * (j & 3));
  }
  unsigned M[16];
  {
    unsigned C[64];
    int n = 0;
#pragma unroll
    for (int i = 0; i < 16; ++i)
#pragma unroll
      for (int j = 0; j < 16; ++j)
        if ((i + 1) * (j + 1) <= 16) {
          const float s = s0[i] + s1[j];
          C[n++] = (srt(s) & ~255u) | (unsigned)(255 - (i * 16 + j));
        }
#pragma unroll
    for (int k = 50; k < 64; ++k) C[k] = 0u;
#pragma unroll
    for (int gi = 0; gi < 4; ++gi) {
      unsigned G[16];
#pragma unroll
      for (int i = 0; i < 16; ++i) G[i] = C[gi * 16 + i];
      bitonic_sort16_desc(G);
      if (gi == 0) {
#pragma unroll
        for (int i = 0; i < 16; ++i) M[i] = G[i];
      } else {
        merge_top16_desc(M, G);
      }
      __builtin_amdgcn_sched_barrier(0);
    }
  }
  float bs[16], den = 0.f;
  unsigned eidx[16];
  const float top = unsrt(M[0] & ~255u);
#pragma unroll
  for (int j = 0; j < 16; ++j) {
    bs[j] = __expf(unsrt(M[j] & ~255u) - top);
    den += bs[j];
    const unsigned code = 255u - (M[j] & 255u);
    const unsigned ci = code >> 4, cj = code & 15u;
    const unsigned wi = ci < 8 ? (ci < 4 ? W0[0] : W0[1]) : (ci < 12 ? W0[2] : W0[3]);
    const unsigned wj = cj < 8 ? (cj < 4 ? W1[0] : W1[1]) : (cj < 12 ? W1[2] : W1[3]);
    eidx[j] = ((wi >> (8 * (ci & 3))) & 127u) * 128u + ((wj >> (8 * (cj & 3))) & 127u);
  }
  const float inv = 1.f / den;
  if (hh == 0) {
    uint4* rt = (uint4*)(p.ws + OFF_GA) + ((size_t)tok * 8 + h) * 8;
#pragma unroll
    for (int j = 0; j < 8; ++j) {
      uint4 o;
      o.x = eidx[2 * j]; o.y = __float_as_uint(bs[2 * j] * inv);
      o.z = eidx[2 * j + 1]; o.w = __float_as_uint(bs[2 * j + 1] * inv);
      rt[j] = o;
    }
  }
}

template <int VAR>
DI void expert_token(const Params& p, int tok, char* ldsw) {
  const int lane = threadIdx.x & 63, c15 = lane & 15, quad = lane >> 4;
  const unsigned char* Ub = (const unsigned char*)(p.ws + OFF_UBF);
  const unsigned char* Vb = (const unsigned char*)(p.ws + OFF_VBF);
  const uint2* rt = (const uint2*)(p.ws + OFF_GA) + (size_t)tok * 128;
  const u16* h2 = (const u16*)(p.ws + OFF_K) + (size_t)tok * 1024;
  uint2 re = rt[c15];
  const uint4 h2a = ld16(h2 + lane * 16), h2b = ld16(h2 + lane * 16 + 8);
  float o[16];
#pragma unroll
  for (int i = 0; i < 16; ++i) o[i] = 0.f;
  uint4 ub[16];
  if (VAR != 2) {
    const unsigned char* urow = Ub + (size_t)re.x * 1024 + quad * 16;
#pragma unroll
    for (int kd = 0; kd < 16; ++kd) ub[kd] = ld16(urow + kd * 64);
  }
  __builtin_amdgcn_sched_barrier(0);
  *(uint4*)(ldsw + lane * 32) = h2a;
  *(uint4*)(ldsw + lane * 32 + 16) = h2b;
  __builtin_amdgcn_fence(__ATOMIC_RELEASE, "wavefront");
  __builtin_amdgcn_wave_barrier();
  __builtin_amdgcn_fence(__ATOMIC_ACQUIRE, "wavefront");
#pragma unroll 1
  for (int hd = 0; hd < 8; ++hd) {
    const int e = (int)re.x;
    const float g = __uint_as_float(re.y);
    const uint2 ren = rt[((hd + 1) & 7) * 16 + c15];
    uint4 vb[16];
    if (VAR != 1) {
#pragma unroll
      for (int j = 0; j < 16; ++j) vb[j] = ld16(Vb + (size_t)__builtin_amdgcn_readlane(e, j) * 1024 + lane * 16);
    }
    __builtin_amdgcn_sched_barrier(0);
    f32x4 acc = {0.f, 0.f, 0.f, 0.f};
    if (VAR != 2)
#pragma unroll
    for (int kd = 0; kd < 16; ++kd) {
      const uint4 bq = ub[kd];
      const bf16x8 a0 = *(const bf16x8*)(ldsw + (kd * 64 + quad * 16) * 2);
      const bf16x8 a1 = *(const bf16x8*)(ldsw + (kd * 64 + quad * 16) * 2 + 16);
      const uint2 b0l = fp8x4_to_bf16x4(bq.x), b0h = fp8x4_to_bf16x4(bq.y), b1l = fp8x4_to_bf16x4(bq.z), b1h = fp8x4_to_bf16x4(bq.w);
      uint4 b0, b1;
      b0.x = b0l.x; b0.y = b0l.y; b0.z = b0h.x; b0.w = b0h.y;
      b1.x = b1l.x; b1.y = b1l.y; b1.z = b1h.x; b1.w = b1h.y;
      acc = mfma16(a0, as_bf(b0), acc);
      acc = mfma16(a1, as_bf(b1), acc);
    }
    const float wgt = g * gelu_tanh(acc[0] * (1.f / U_SCALE)) * (1.f / V_SCALE);
    if (hd + 1 < 8) {
      re = ren;
      if (VAR != 2) {
        const unsigned char* urow = Ub + (size_t)re.x * 1024 + quad * 16;
#pragma unroll
        for (int kd = 0; kd < 16; ++kd) ub[kd] = ld16(urow + kd * 64);
      }
    }
    __builtin_amdgcn_sched_barrier(0);
    if (VAR == 1) { o[hd] += wgt; continue; }
#pragma unroll
    for (int j = 0; j < 16; ++j) {
      const float wj = __uint_as_float(__builtin_amdgcn_readlane(__float_as_uint(wgt), j));
      const uint4 v = vb[j];
      f32x2 t;
      t = __builtin_amdgcn_cvt_pk_f32_fp8((int)v.x, false); o[0] += wj * t[0]; o[1] += wj * t[1];
      t = __builtin_amdgcn_cvt_pk_f32_fp8((int)v.x, true);  o[2] += wj * t[0]; o[3] += wj * t[1];
      t = __builtin_amdgcn_cvt_pk_f32_fp8((int)v.y, false); o[4] += wj * t[0]; o[5] += wj * t[1];
      t = __builtin_amdgcn_cvt_pk_f32_fp8((int)v.y, true);  o[6] += wj * t[0]; o[7] += wj * t[1];
      t = __builtin_amdgcn_cvt_pk_f32_fp8((int)v.z, false); o[8] += wj * t[0]; o[9] += wj * t[1];
      t = __builtin_amdgcn_cvt_pk_f32_fp8((int)v.z, true);  o[10] += wj * t[0]; o[11] += wj * t[1];
      t = __builtin_amdgcn_cvt_pk_f32_fp8((int)v.w, false); o[12] += wj * t[0]; o[13] += wj * t[1];
      t = __builtin_amdgcn_cvt_pk_f32_fp8((int)v.w, true);  o[14] += wj * t[0]; o[15] += wj * t[1];
      __builtin_amdgcn_sched_barrier(0);
    }
  }
  if (VAR != 0) {
    float sacc_ = 0.f;
#pragma unroll
    for (int i = 0; i < 16; ++i) sacc_ += o[i];
    if (sacc_ == 12345.678f) ((float*)(p.ws + OFF_CUM))[lane] = sacc_;
    return;
  }
  float4* out = (float4*)(p.out + (size_t)tok * 1024 + lane * 16);
  float4 x0 = out[0], x1 = out[1], x2 = out[2], x3 = out[3];
  x0.x += o[0]; x0.y += o[1]; x0.z += o[2]; x0.w += o[3];
  x1.x += o[4]; x1.y += o[5]; x1.z += o[6]; x1.w += o[7];
  x2.x += o[8]; x2.y += o[9]; x2.z += o[10]; x2.w += o[11];
  x3.x += o[12]; x3.y += o[13]; x3.z += o[14]; x3.w += o[15];
  out[0] = x0; out[1] = x1; out[2] = x2; out[3] = x3;
  __builtin_amdgcn_fence(__ATOMIC_RELEASE, "wavefront");
  __builtin_amdgcn_wave_barrier();
  __builtin_amdgcn_fence(__ATOMIC_ACQUIRE, "wavefront");
}

template <class F>
DI void walk_tiles(int NT, int nw, F&& f) {
  const int x = blockIdx.x & 7, j = blockIdx.x >> 3, nloc = gridDim.x >> 3;
  const int mpc = 64 / nw;
  const int ngr = (NT + nw - 1) / nw, mgr = 32 / mpc;
  for (int c = 0; c < mgr * ngr; ++c) {
    const int mg = c / ngr, ng = c % ngr;
    for (int u = j; u < 64; u += nloc) {
      const int mt = 32 * x + mg * mpc + (u % mpc), nt = ng * nw + u / mpc;
      if (nt < NT) f(mt, nt);
    }
  }
}

#define XB_TMO      128
#define XB_XCNT(j)  (256  + 64 * (j))
#define XB_XSUB(j)  (1280 + 64 * (j))
#define XB_XGEN(j)  (2304 + 64 * (j))
#define XB_TOP      3328
#define XB_TOPGEN   3392
#define XCD_BAR_WORDS 3456
#define XB_SPIN_CAP (1u << 22)
#define LAS __attribute__((address_space(3)))
DI unsigned xb_ld(unsigned* p) { return __hip_atomic_load(p, __ATOMIC_RELAXED, __HIP_MEMORY_SCOPE_AGENT); }
DI unsigned xb_add(unsigned* p, unsigned v) { return __hip_atomic_fetch_add(p, v, __ATOMIC_RELAXED, __HIP_MEMORY_SCOPE_AGENT); }
DI unsigned xb_xcc_id() { return (unsigned)__builtin_amdgcn_s_getreg((3 << 11) | 20) & 0xFu; }
#define XB_SPIN(cond, bar) do { unsigned _sp = 0; while (cond) { __builtin_amdgcn_s_sleep(1); \
    if ((++_sp & 255u) == 0u) { if (xb_ld(&(bar)[XB_TMO])) break; if (_sp > XB_SPIN_CAP) { atomicAdd(&(bar)[XB_TMO], 1u); break; } } } } while (0)
struct XcdBarrier { unsigned* bar; unsigned x; volatile LAS unsigned* st; };
DI XcdBarrier xcd_barrier_post(unsigned* bar, volatile LAS unsigned* st) {
  XcdBarrier b; b.bar = bar; b.x = xb_xcc_id(); b.st = st;
  if (threadIdx.x == 0) (void)xb_add(&bar[XB_XCNT(b.x)], 1u);
  return b;
}
DI void xcd_barrier_complete(unsigned* bar, unsigned x, unsigned& nloc, unsigned& nx) {
  const unsigned G = gridDim.x * gridDim.y * gridDim.z;
  unsigned sum, cnt, mine, sp = 0u;
  for (;;) {
    sum = 0u; cnt = 0u; mine = 0u;
#pragma unroll
    for (unsigned j = 0; j < 16; ++j) { const unsigned c = xb_ld(&bar[XB_XCNT(j)]); sum += c; cnt += (c > 0u) ? 1u : 0u; mine = (j == x) ? c : mine; }
    if (sum == G) break;
    __builtin_amdgcn_s_sleep(1);
    if ((++sp & 255u) == 0u) { if (xb_ld(&bar[XB_TMO])) break; if (sp > XB_SPIN_CAP) { atomicAdd(&bar[XB_TMO], 1u); break; } }
  }
  nloc = mine > 0u ? mine : 1u; nx = cnt > 0u ? cnt : 1u;
}
DI void xcd_barrier(const XcdBarrier& b) {
  asm volatile("s_waitcnt vmcnt(0)" ::: "memory");
  __syncthreads();
  if (threadIdx.x == 0) {
    unsigned* bar = b.bar;
    __builtin_amdgcn_s_waitcnt(0);
    unsigned nloc = b.st[0], nx = b.st[1];
    if (nloc == 0u) { xcd_barrier_complete(bar, b.x, nloc, nx); b.st[0] = nloc; b.st[1] = nx; }
    const unsigned old = xb_add(&bar[XB_XSUB(b.x)], 1u);
    const unsigned gen = old / nloc;
    if (old + 1u == (gen + 1u) * nloc) {
      __builtin_amdgcn_fence(__ATOMIC_RELEASE, "agent");
      asm volatile("s_waitcnt vmcnt(0)" ::: "memory");
      const unsigned og = xb_add(&bar[XB_TOP], 1u);
      const unsigned tg = og / nx;
      if (og + 1u == (tg + 1u) * nx) xb_add(&bar[XB_TOPGEN], 1u);
      else XB_SPIN(xb_ld(&bar[XB_TOPGEN]) == tg, bar);
      __builtin_amdgcn_fence(__ATOMIC_ACQUIRE, "agent");
      xb_add(&bar[XB_XGEN(b.x)], 1u);
      asm volatile("s_waitcnt vmcnt(0)" ::: "memory");
    } else {
      XB_SPIN(xb_ld(&bar[XB_XGEN(b.x)]) == gen, bar);
      __builtin_amdgcn_fence(__ATOMIC_ACQUIRE, "agent");
      asm volatile("s_waitcnt vmcnt(0)" ::: "memory");
    }
  }
  __syncthreads();
}

template <int PH>
DI void run_phase(const Params& p, char* lds) {
  const int tid = threadIdx.x, w = tid >> 6;
  if (PH == 0) {
    phase_prep(p, lds);
  } else if (PH == 1) {
    {
      const int x = blockIdx.x & 7, j = blockIdx.x >> 3, nloc = gridDim.x >> 3;
      for (int c = 0; c < 11; ++c)
        for (int u = j; u < 64; u += nloc) {
          int mt, nt;
          if (c < 10) { mt = 32 * x + 16 * (c / 5) + (u & 15); nt = 4 * (c % 5) + (u >> 4); }
          else { mt = 32 * x + (u & 31); nt = 20 + (u >> 5); }
          gemm_tile<1024, G_INPROJ>(p, (const u16*)(p.ws + OFF_H), (const u16*)(p.ws + OFF_WIN), mt, nt, lds);
        }
    }
  } else if (PH == 2 || PH == 12 || PH == 13) {
    int* ctr = (int*)(p.ws + OFF_CTR) + (blockIdx.x & 7) + (PH == 2 ? 0 : 8);
    const int x = blockIdx.x & 7;
    int* s_item = (int*)(lds + LDS_BYTES - 16);
    for (;;) {
      __syncthreads();
      if (tid == 0) *s_item = atomicAdd(ctr, 1);
      __syncthreads();
      const int it = *s_item;
      if (it >= 32 + 256) break;
      if (it < 32) {
        if (PH != 13) s5_item<1>(p, x * 32 + it, w, lds + w * 17920);
      } else {
        const int a = it - 32;
        attn_item(p, x * 8 + (a & 7), 31 - (a >> 3), lds);
      }
    }
  } else if (PH == 3) {
    walk_tiles(8, 8, [&](int mt, int nt) {
      gemm_tile<512, G_GLU>(p, (const u16*)(p.ws + OFF_U), (const u16*)(p.ws + OFF_WGLU), mt, nt, lds);
    });
  } else if (PH == 4) {
    walk_tiles(4, 4, [&](int mt, int nt) {
      gemm_tile<1024, G_OUT>(p, (const u16*)(p.ws + OFF_H), (const u16*)(p.ws + OFF_WOUT), mt, nt, lds);
    });
  } else if (PH == 5) {
    rmsnorm_rows_t<false>(p, p.out, p.ffn_g, (u16*)(p.ws + OFF_K));
  } else if (PH == 6) {
    walk_tiles(8, 8, [&](int mt, int nt) {
      gemm_tile<1024, G_PQ>(p, (const u16*)(p.ws + OFF_K), (const u16*)(p.ws + OFF_WQ), mt, nt, lds);
    });
  } else if (PH == 7) {
    const int gw = blockIdx.x * 4 + w, nw = gridDim.x * 4;
    {
      const int h = blockIdx.x & 7, jb = blockIdx.x >> 3, nloc = gridDim.x >> 3;
      const u16* skg = (const u16*)(p.ws + OFF_SK) + (size_t)h * 256 * 128;
#pragma unroll 4
      for (int i = 0; i < 16; ++i) {
        const int ci = tid + 256 * i, row = ci >> 4, pc = ci & 15, gc = pc ^ (row & 15);
        *(uint4*)(lds + row * 256 + pc * 16) = ld16(skg + row * 128 + gc * 8);
      }
      __syncthreads();
      for (int tt = jb * 4 + w; tt < 1024; tt += nloc * 4) route_item(p, tt, h, lds);
      __syncthreads();
    }
    {
      const size_t nthr = (size_t)gridDim.x * 256, gtid = (size_t)blockIdx.x * 256 + tid;
      cvt_rows_fp8(p.peer_u, (unsigned char*)(p.ws + OFF_UBF), 16384ull * 1024 / 16, U_SCALE, gtid, nthr);
      cvt_rows_fp8(p.peer_v, (unsigned char*)(p.ws + OFF_VBF), 16384ull * 1024 / 16, V_SCALE, gtid, nthr);
    }
  } else if (PH == 8) {
    const int gw = blockIdx.x * 4 + w, nw = gridDim.x * 4;
    for (int tok = gw; tok < NTOK; tok += nw) expert_token<0>(p, tok, lds + w * 2048);
  } else if (PH == 14) {
    const int gw = blockIdx.x * 4 + w, nw = gridDim.x * 4;
    for (int tok = gw; tok < NTOK; tok += nw) expert_token<1>(p, tok, lds + w * 2048);
  } else if (PH == 15) {
    const int gw = blockIdx.x * 4 + w, nw = gridDim.x * 4;
    for (int tok = gw; tok < NTOK; tok += nw) expert_token<2>(p, tok, lds + w * 2048);
  } else if (PH == 9) {
    const int gw = blockIdx.x * 4 + w;
    if (gw < 64) cumsum_item(p, gw);
    const int nw9 = gridDim.x * 4;
    for (int it = nw9 - 1 - gw; it < 768; it += nw9) s5_item<0>(p, it / 3, it % 3, lds + w * 17920);
    qknorm_rows(p);
  }
}

template <int MODE>
__global__ __launch_bounds__(256, 2) void mk(Params p) {
  extern __shared__ __attribute__((aligned(16))) char lds[];
  if (MODE >= 0) {
    run_phase<MODE>(p, lds);
  } else {
    cg::grid_group grid = cg::this_grid();
    volatile LAS unsigned* st = (volatile LAS unsigned*)(lds + LDS_BYTES - 32);
    if (threadIdx.x == 0) { st[0] = 0u; st[1] = 0u; }
    __syncthreads();
    const XcdBarrier xb = xcd_barrier_post((unsigned*)(p.ws + OFF_BAR), st);
    if (p.out == nullptr) grid.sync();
    run_phase<0>(p, lds); xcd_barrier(xb);
    run_phase<1>(p, lds); xcd_barrier(xb);
    run_phase<9>(p, lds); xcd_barrier(xb);
    run_phase<2>(p, lds); xcd_barrier(xb);
    run_phase<3>(p, lds); xcd_barrier(xb);
    run_phase<4>(p, lds); xcd_barrier(xb);
    run_phase<5>(p, lds); xcd_barrier(xb);
    run_phase<6>(p, lds); xcd_barrier(xb);
    run_phase<7>(p, lds); xcd_barrier(xb);
    run_phase<8>(p, lds);
#ifdef EXPF
#if EXPF == 1
    for (int i = 0; i < 10; ++i) grid.sync();
#elif EXPF == 2
    grid.sync(); run_phase<1>(p, lds);
#endif
#endif
  }
}


template <int D>
__global__ void mk_dump(Params p) {
  const size_t n = (size_t)NTOK * 1024;
  for (size_t i = (size_t)blockIdx.x * 256 + threadIdx.x; i < n; i += (size_t)gridDim.x * 256) {
    const size_t tok = i >> 10, c = i & 1023;
    float v = 0.f;
    if (D == 1) {
#if DUMPSUB == 0
      v = bf2f(((const u16*)(p.ws + OFF_U))[tok * 512 + (c & 511)]);
#elif DUMPSUB == 1
      v = bf2f(((const u16*)(p.ws + OFF_V))[i]) + bf2f(((const u16*)(p.ws + OFF_GS))[i]) + bf2f(((const u16*)(p.ws + OFF_GA))[i]);
#elif DUMPSUB == 2
      v = bf2f(((const u16*)(p.ws + OFF_Q))[i]) + bf2f(((const u16*)(p.ws + OFF_K))[i]);
#else
      v = ((const float*)(p.ws + OFF_LOGF))[i & 262143];
#endif
    } else if (D == 11) {
      v = bf2f(((const u16*)(p.ws + OFF_Q))[i]) + bf2f(((const u16*)(p.ws + OFF_K))[i]) + bf2f(((const u16*)(p.ws + OFF_V))[i]) +
          bf2f(((const u16*)(p.ws + OFF_GS))[i]) + bf2f(((const u16*)(p.ws + OFF_GA))[i]) + bf2f(((const u16*)(p.ws + OFF_U))[tok * 512 + (c & 511)]) +
          ((const float*)(p.ws + OFF_LOGF))[i & 262143];
    } else if (D == 2) {
      v = bf2f(((const u16*)(p.ws + OFF_Q))[i]);
    } else if (D == 3) {
      v = bf2f(((const u16*)(p.ws + OFF_U))[tok * 512 + (c & 511)]);
    } else if (D == 4) {
      v = bf2f(((const u16*)(p.ws + OFF_H))[i]);
    } else if (D == 5) {
      v = bf2f(((const u16*)(p.ws + OFF_H))[i]) + bf2f(((const u16*)(p.ws + OFF_WIN))[i % (5760 * 1024)]) + bf2f(((const u16*)(p.ws + OFF_WQ))[i & (2048 * 1024 - 1)]);
    }
    p.out[i] = v;
  }
}

extern "C" void kernel_launch(void* const* d_in, const int* in_sizes, int n_in, void* d_out, int out_size, void* d_ws,
                              size_t ws_size, hipStream_t stream) {
  if (ws_size < WS_NEED) { fprintf(stderr, "workspace too small: %zu < %zu\n", ws_size, (size_t)WS_NEED); return; }
  Params p{};
  const float** f = (const float**)&p;
  for (int i = 0; i < 21; ++i) f[i] = (const float*)d_in[i];
  p.out = (float*)d_out;
  p.ws = (char*)d_ws;
#if FUSED
  static int grid_blocks = 0;
  if (!grid_blocks) {
    int dev = 0, cus = 0, per_cu = 0;
    hipGetDevice(&dev);
    hipDeviceGetAttribute(&cus, hipDeviceAttributeMultiprocessorCount, dev);
    hipFuncSetAttribute((const void*)mk<-1>, hipFuncAttributeMaxDynamicSharedMemorySize, LDS_BYTES);
    hipOccupancyMaxActiveBlocksPerMultiprocessor(&per_cu, mk<-1>, 256, LDS_BYTES);
    if (per_cu > 2) per_cu = 2;
    grid_blocks = cus * per_cu;
  }
  hipMemsetAsync((char*)d_ws + OFF_BAR, 0, XCD_BAR_WORDS * 4, stream);
  void* args[] = {&p};
  hipError_t e = hipLaunchCooperativeKernel((void*)mk<-1>, dim3(grid_blocks), dim3(256), args, LDS_BYTES, stream);
  if (e != hipSuccess) fprintf(stderr, "cooperative launch failed: %s (grid %d)\n", hipGetErrorString(e), grid_blocks);
#else
  const int G = 512;
  static bool attr_done = false;
  if (!attr_done) {
    hipFuncSetAttribute((const void*)mk<0>, hipFuncAttributeMaxDynamicSharedMemorySize, LDS_BYTES);
    hipFuncSetAttribute((const void*)mk<1>, hipFuncAttributeMaxDynamicSharedMemorySize, LDS_BYTES);
    hipFuncSetAttribute((const void*)mk<2>, hipFuncAttributeMaxDynamicSharedMemorySize, LDS_BYTES);
    hipFuncSetAttribute((const void*)mk<3>, hipFuncAttributeMaxDynamicSharedMemorySize, LDS_BYTES);
    hipFuncSetAttribute((const void*)mk<4>, hipFuncAttributeMaxDynamicSharedMemorySize, LDS_BYTES);
    hipFuncSetAttribute((const void*)mk<5>, hipFuncAttributeMaxDynamicSharedMemorySize, LDS_BYTES);
    hipFuncSetAttribute((const void*)mk<6>, hipFuncAttributeMaxDynamicSharedMemorySize, LDS_BYTES);
    hipFuncSetAttribute((const void*)mk<7>, hipFuncAttributeMaxDynamicSharedMemorySize, LDS_BYTES);
    hipFuncSetAttribute((const void*)mk<8>, hipFuncAttributeMaxDynamicSharedMemorySize, LDS_BYTES);
    hipFuncSetAttribute((const void*)mk<9>, hipFuncAttributeMaxDynamicSharedMemorySize, LDS_BYTES);
    hipFuncSetAttribute((const void*)mk<12>, hipFuncAttributeMaxDynamicSharedMemorySize, LDS_BYTES);
    hipFuncSetAttribute((const void*)mk<14>, hipFuncAttributeMaxDynamicSharedMemorySize, LDS_BYTES);
    hipFuncSetAttribute((const void*)mk<15>, hipFuncAttributeMaxDynamicSharedMemorySize, LDS_BYTES);
    hipFuncSetAttribute((const void*)mk<13>, hipFuncAttributeMaxDynamicSharedMemorySize, LDS_BYTES);
    attr_done = true;
  }
  mk<0><<<G, 256, LDS_BYTES, stream>>>(p);
#ifdef DUMP
#if DUMP == 5
  mk_dump<5><<<1024, 256, 0, stream>>>(p); return;
#endif
#endif
  mk<1><<<G, 256, LDS_BYTES, stream>>>(p);
  mk<9><<<G, 256, LDS_BYTES, stream>>>(p);
#ifdef DUMP
#if DUMP == 1
  mk_dump<1><<<1024, 256, 0, stream>>>(p); return;
#endif
#endif
  mk<2><<<G, 256, LDS_BYTES, stream>>>(p);
#ifdef DUMP
#if DUMP == 2
  mk_dump<2><<<1024, 256, 0, stream>>>(p); return;
#elif DUMP == 3
  mk_dump<3><<<1024, 256, 0, stream>>>(p); return;
#endif
#endif
  mk<3><<<G, 256, LDS_BYTES, stream>>>(p);
#ifdef DUMP
#if DUMP == 4
  mk_dump<4><<<1024, 256, 0, stream>>>(p); return;
#endif
#endif
  mk<4><<<G, 256, LDS_BYTES, stream>>>(p);
#ifndef LASTPH
#define LASTPH 8
#endif
#if LASTPH >= 5
  mk<5><<<G, 256, LDS_BYTES, stream>>>(p);
  mk<6><<<G, 256, LDS_BYTES, stream>>>(p);
  mk<7><<<G, 256, LDS_BYTES, stream>>>(p);
#endif
#if LASTPH >= 8
  mk<8><<<G, 256, LDS_BYTES, stream>>>(p);
#endif
#ifdef EXP
#if EXP == 1
  mk<4><<<G, 256, LDS_BYTES, stream>>>(p);
  mk<8><<<G, 256, LDS_BYTES, stream>>>(p);
#elif EXP == 2
  mk<1><<<G, 256, LDS_BYTES, stream>>>(p);
#elif EXP == 14
  mk<14><<<G, 256, LDS_BYTES, stream>>>(p);
#elif EXP == 15
  mk<15><<<G, 256, LDS_BYTES, stream>>>(p);
#elif EXP == 7
  mk<12><<<G, 256, LDS_BYTES, stream>>>(p);
#elif EXP == 8
  mk<13><<<G, 256, LDS_BYTES, stream>>>(p);
#elif EXP == 5
  mk<7><<<G, 256, LDS_BYTES, stream>>>(p);
#elif EXP == 6
  mk<0><<<G, 256, LDS_BYTES, stream>>>(p);
#elif EXP == 3
  mk<3><<<G, 256, LDS_BYTES, stream>>>(p);
  mk<6><<<G, 256, LDS_BYTES, stream>>>(p);
  mk<7><<<G, 256, LDS_BYTES, stream>>>(p);
#endif
#endif
#endif
}
```
